# Optimizing an MI355X kernel written in HIP

```python
import jax, jax.numpy as jnp
from jax import lax
import numpy as np

D_MODEL = 2048
BATCH = 4
SEQ = 2048
DEPTH = 1
DEC_BATCH = 128
DEC_SEQ = 8
PAST_LEN = 16384
PAGE_SIZE = 128

MIX_WIDTH = D_MODEL // 2
RWKV_HEAD_DIM = 64
RWKV_HEADS = MIX_WIDTH // RWKV_HEAD_DIM
DECAY_RANK = 64
AAA_RANK = 64
GATE_RANK = 128
SGU_CHUNK = 128
SGU_GROUPS = 8
SGU_GROUP_DIM = MIX_WIDTH // SGU_GROUPS
XATTN_HEADS = 4
XATTN_HEAD_DIM = MIX_WIDTH // XATTN_HEADS
MEM_LEN = 256
N_BRANCH = 3
D_FF = 11 * D_MODEL // 4
CONV_WIDTH = 3
RMS_EPS = 1e-6
LN_EPS = 1e-5
GN_EPS = 64e-5
N_SHIFT = 3 * MIX_WIDTH + DECAY_RANK + AAA_RANK + GATE_RANK
N_IN = N_SHIFT + 2 * MIX_WIDTH + MIX_WIDTH + N_BRANCH * D_MODEL

kernel_name = 'rwkv7_sgu_memxattn_gated_hybrid_step'


def rmsnorm(x, g):
    xf = x.astype(jnp.float32)
    y = xf * lax.rsqrt(jnp.mean(xf * xf, axis=-1, keepdims=True) + RMS_EPS)
    return (y * g.astype(jnp.float32)).astype(x.dtype)


def rwkv7_mix(rw, wkv0, w0, w_decay, a0, w_aaa, w_gate, k_k, k_a, r_k, lnx_w, lnx_b):
    f32 = jnp.float32
    B, T, _ = rw.shape
    W = MIX_WIDTH
    r, k, v, xw, xa, xg = jnp.split(rw.astype(f32), [W, 2 * W, 3 * W, 3 * W + DECAY_RANK, 3 * W + DECAY_RANK + AAA_RANK], axis=-1)
    w_log = -jax.nn.softplus(-(w0.astype(f32) + jnp.tanh(xw) @ w_decay.astype(f32))) - 0.5
    decay = jnp.exp(-jnp.exp(w_log))
    a = jax.nn.sigmoid(a0.astype(f32) + xa @ w_aaa.astype(f32))
    g = jax.nn.sigmoid(xg) @ w_gate.astype(f32)
    kk = k * k_k.astype(f32)
    k = k * (1.0 + (a - 1.0) * k_a.astype(f32))
    heads = lambda t: t.reshape(B, T, RWKV_HEADS, RWKV_HEAD_DIM)
    kk = heads(kk)
    kk = kk / jnp.maximum(jnp.sqrt(jnp.sum(kk * kk, axis=-1, keepdims=True)), 1e-12)
    r_h, k_h, v_h, w_h, a_h = heads(r), heads(k), heads(v), heads(decay), heads(a)
    a_vec = -kk
    b_vec = kk * a_h

    def step(S, inp):
        r_t, w_t, k_t, v_t, av_t, bv_t = inp
        sa = jnp.einsum('bhvk,bhk->bhv', S, av_t)
        S = S * w_t[:, :, None, :] + sa[..., None] * bv_t[:, :, None, :] + v_t[..., None] * k_t[:, :, None, :]
        return S, jnp.einsum('bhvk,bhk->bhv', S, r_t)

    seq = tuple(jnp.moveaxis(t, 1, 0) for t in (r_h, w_h, k_h, v_h, a_vec, b_vec))
    S, ys = lax.scan(step, wkv0.astype(f32), seq)
    y = jnp.moveaxis(ys, 0, 1)
    mu = jnp.mean(y, axis=-1, keepdims=True)
    var = jnp.mean(jnp.square(y - mu), axis=-1, keepdims=True)
    yn = ((y - mu) * lax.rsqrt(var + GN_EPS)).reshape(B, T, W) * lnx_w.astype(f32) + lnx_b.astype(f32)
    bonus = jnp.sum(r_h * k_h * r_k.astype(f32), axis=-1, keepdims=True) * v_h
    out = (yn + bonus.reshape(B, T, W)) * g
    return out.astype(rw.dtype), S.astype(wkv0.dtype)


def sgu_mix(gu, gv, sgu_g, sgu_b, w_s, b_s):
    B, T, W = gv.shape
    u = jax.nn.gelu(gu)
    vf = jax.nn.gelu(gv).astype(jnp.float32)
    mu = jnp.mean(vf, axis=-1, keepdims=True)
    var = jnp.mean(jnp.square(vf - mu), axis=-1, keepdims=True)
    v = (((vf - mu) * lax.rsqrt(var + LN_EPS)) * sgu_g.astype(jnp.float32) + sgu_b.astype(jnp.float32)).astype(gv.dtype)
    n_chunks = -(-T // SGU_CHUNK)
    pad = n_chunks * SGU_CHUNK - T
    vp = jnp.pad(v, ((0, 0), (0, pad), (0, 0))).reshape(B, n_chunks, SGU_CHUNK, SGU_GROUPS, SGU_GROUP_DIM)
    tril = jnp.tril(jnp.ones((SGU_CHUNK, SGU_CHUNK), dtype=bool))
    ws = jnp.where(tril, w_s, jnp.zeros_like(w_s))
    s = jnp.einsum('gts,bnsgc->bntgc', ws, vp) + jnp.transpose(b_s)[None, None, :, :, None]
    s = s.reshape(B, n_chunks * SGU_CHUNK, W)[:, :T]
    return u * s, v


def memory_kv(mem, g_mem, w_mem_k, w_mem_v):
    B, M, _ = mem.shape
    mn = rmsnorm(mem, g_mem)
    k = (mn @ w_mem_k).reshape(B, M, XATTN_HEADS, XATTN_HEAD_DIM)
    v = (mn @ w_mem_v).reshape(B, M, XATTN_HEADS, XATTN_HEAD_DIM)
    return k, v


def mem_xattn(q, mem_k, mem_v):
    B, T, _ = q.shape
    qh = q.reshape(B, T, XATTN_HEADS, XATTN_HEAD_DIM)
    s = jnp.einsum('bthd,bmhd->bhtm', qh, mem_k).astype(jnp.float32) * (XATTN_HEAD_DIM ** -0.5)
    pr = jax.nn.softmax(s, axis=-1).astype(q.dtype)
    return jnp.einsum('bhtm,bmhd->bthd', pr, mem_v).reshape(B, T, MIX_WIDTH)


def conv_ffn(h, conv_prev, w_up, conv_w, conv_b, w_down):
    T = h.shape[1]
    up = h @ w_up
    ext = jnp.concatenate([conv_prev.astype(up.dtype), up], axis=1)
    conv = conv_b + sum(conv_w[j] * ext[:, j:j + T] for j in range(CONV_WIDTH))
    gate, val = jnp.split(conv, 2, axis=-1)
    out = (jax.nn.gelu(gate) * val) @ w_down
    return out, ext[:, -(CONV_WIDTH - 1):]


def layer(x, shift_prev, wkv0, mem_k, mem_v, conv_prev, p):
    B, T, _ = x.shape
    xn = rmsnorm(x, p['g_pre_mix'])
    proj = xn @ p['w_in']
    W = MIX_WIDTH
    rw, gu, gv, q, gt = jnp.split(proj, [N_SHIFT, N_SHIFT + W, N_SHIFT + 2 * W, N_SHIFT + 3 * W], axis=-1)
    prev = jnp.concatenate([shift_prev[:, None, :].astype(rw.dtype), rw[:, :-1]], axis=1)
    rw_s = rw + p['mu_shift'] * (prev - rw)
    a_out, wkv_new = rwkv7_mix(rw_s, wkv0, p['w0'], p['w_decay'], p['a0'], p['w_aaa'], p['w_gate'],
                               p['k_k'], p['k_a'], p['r_k'], p['lnx_w'], p['lnx_b'])
    b_out, v_rows = sgu_mix(gu, gv, p['sgu_g'], p['sgu_b'], p['w_s'], p['b_s'])
    c_out = mem_xattn(q, mem_k, mem_v)
    branches = jnp.stack([a_out, b_out, c_out], axis=2)
    br = jnp.einsum('btnw,nwd->btnd', branches, p['w_branch'])
    gates = jax.nn.sigmoid(gt.reshape(B, T, N_BRANCH, D_MODEL))
    mix = jnp.sum(gates * br, axis=2) @ p['w_out']
    h = x + rmsnorm(mix, p['g_post_mix'])
    f, conv_new = conv_ffn(rmsnorm(h, p['g_pre_ffn']), conv_prev, p['w_up'], p['conv_w'], p['conv_b'], p['w_down'])
    y = h + rmsnorm(f, p['g_post_ffn'])
    return y, rw[:, -1], wkv_new, v_rows, conv_new


def setup_inputs(seed: int = 0) -> dict:
    key = jax.random.key(seed)
    ks = iter(jax.random.split(key, 48))
    f32 = jnp.float32
    L, D, W, F2 = DEPTH, D_MODEL, MIX_WIDTH, 2 * D_FF
    nrm = lambda shape, s: jax.random.normal(next(ks), shape, f32) * s
    gain = lambda shape: 1.0 + nrm(shape, 0.05)
    return {
        'x_prompt': nrm((BATCH, SEQ, D), 1.0),
        'x_sample': nrm((DEC_BATCH, DEC_SEQ, D), 1.0),
        'mem_prompt': nrm((BATCH, MEM_LEN, D), 1.0),
        'state_wkv': nrm((L, DEC_BATCH, RWKV_HEADS, RWKV_HEAD_DIM, RWKV_HEAD_DIM), 0.3),
        'state_shift': nrm((L, DEC_BATCH, N_SHIFT), 1.0),
        'cache_mem_k': nrm((L, DEC_BATCH, MEM_LEN, XATTN_HEADS, XATTN_HEAD_DIM), 1.0),
        'cache_mem_v': nrm((L, DEC_BATCH, MEM_LEN, XATTN_HEADS, XATTN_HEAD_DIM), 1.0),
        'state_ffn_conv': nrm((L, DEC_BATCH, CONV_WIDTH - 1, F2), 1.0),
        'g_pre_mix': gain((L, D)),
        'w_in': nrm((L, D, N_IN), D ** -0.5),
        'mu_shift': jax.random.uniform(next(ks), (L, N_SHIFT), f32),
        'w0': jax.random.uniform(next(ks), (L, W), f32, -5.0, -0.5),
        'w_decay': nrm((L, DECAY_RANK, W), DECAY_RANK ** -0.5),
        'a0': nrm((L, W), 0.5),
        'w_aaa': nrm((L, AAA_RANK, W), AAA_RANK ** -0.5),
        'w_gate': nrm((L, GATE_RANK, W), GATE_RANK ** -0.5),
        'k_k': 0.85 + nrm((L, W), 0.05),
        'k_a': gain((L, W)),
        'r_k': nrm((L, RWKV_HEADS, RWKV_HEAD_DIM), 0.1),
        'lnx_w': gain((L, W)),
        'lnx_b': nrm((L, W), 0.02),
        'sgu_g': gain((L, W)),
        'sgu_b': nrm((L, W), 0.02),
        'w_s': nrm((L, SGU_GROUPS, SGU_CHUNK, SGU_CHUNK), SGU_CHUNK ** -0.5),
        'b_s': 1.0 + nrm((L, SGU_GROUPS, SGU_CHUNK), 0.1),
        'g_mem': gain((L, D)),
        'w_mem_k': nrm((L, D, W), D ** -0.5),
        'w_mem_v': nrm((L, D, W), D ** -0.5),
        'w_branch': nrm((L, N_BRANCH, W, D), W ** -0.5),
        'w_out': nrm((L, D, D), D ** -0.5),
        'g_post_mix': gain((L, D)),
        'g_pre_ffn': gain((L, D)),
        'w_up': nrm((L, D, F2), D ** -0.5),
        'conv_w': nrm((L, CONV_WIDTH, F2), CONV_WIDTH ** -0.5),
        'conv_b': nrm((L, F2), 0.02),
        'w_down': nrm((L, D_FF, D), D_FF ** -0.5),
        'g_post_ffn': gain((L, D)),
    }


def reference(x_prompt, x_sample, mem_prompt, state_wkv, state_shift, cache_mem_k, cache_mem_v, state_ffn_conv,
              g_pre_mix, w_in, mu_shift, w0, w_decay, a0, w_aaa, w_gate, k_k, k_a, r_k, lnx_w, lnx_b,
              sgu_g, sgu_b, w_s, b_s, g_mem, w_mem_k, w_mem_v, w_branch, w_out, g_post_mix, g_pre_ffn,
              w_up, conv_w, conv_b, w_down, g_post_ffn):
    y_p, y_s = x_prompt, x_sample
    B = x_prompt.shape[0]
    wkv_p_l, sh_p_l, mk_p_l, mv_p_l, cv_p_l = [], [], [], [], []
    wkv_s_l, sh_s_l, vr_s_l, cv_s_l = [], [], [], []
    for l in range(DEPTH):
        p = dict(g_pre_mix=g_pre_mix[l], w_in=w_in[l], mu_shift=mu_shift[l], w0=w0[l], w_decay=w_decay[l],
                 a0=a0[l], w_aaa=w_aaa[l], w_gate=w_gate[l], k_k=k_k[l], k_a=k_a[l], r_k=r_k[l],
                 lnx_w=lnx_w[l], lnx_b=lnx_b[l], sgu_g=sgu_g[l], sgu_b=sgu_b[l], w_s=w_s[l], b_s=b_s[l],
                 w_branch=w_branch[l], w_out=w_out[l], g_post_mix=g_post_mix[l], g_pre_ffn=g_pre_ffn[l],
                 w_up=w_up[l], conv_w=conv_w[l], conv_b=conv_b[l], w_down=w_down[l], g_post_ffn=g_post_ffn[l])
        mk_p, mv_p = memory_kv(mem_prompt, g_mem[l], w_mem_k[l], w_mem_v[l])
        shift0 = jnp.zeros((B, N_SHIFT), x_prompt.dtype)
        wkv0 = jnp.zeros((B, RWKV_HEADS, RWKV_HEAD_DIM, RWKV_HEAD_DIM), x_prompt.dtype)
        conv0 = jnp.zeros((B, CONV_WIDTH - 1, 2 * D_FF), x_prompt.dtype)
        y_p, sh_p, wkv_p, _, cv_p = layer(y_p, shift0, wkv0, mk_p, mv_p, conv0, p)
        y_s, sh_s, wkv_s, vr_s, cv_s = layer(y_s, state_shift[l], state_wkv[l], cache_mem_k[l], cache_mem_v[l],
                                             state_ffn_conv[l], p)
        wkv_p_l.append(wkv_p); sh_p_l.append(sh_p); mk_p_l.append(mk_p); mv_p_l.append(mv_p); cv_p_l.append(cv_p)
        wkv_s_l.append(wkv_s); sh_s_l.append(sh_s); vr_s_l.append(vr_s); cv_s_l.append(cv_s)
    new_wkv_prompt = jnp.stack(wkv_p_l)
    new_shift_prompt = jnp.stack(sh_p_l)
    new_mem_k_prompt = jnp.stack(mk_p_l)
    new_mem_v_prompt = jnp.stack(mv_p_l)
    new_ffn_conv_prompt = jnp.stack(cv_p_l)
    new_wkv_sample = jnp.stack(wkv_s_l)
    new_shift_sample = jnp.stack(sh_s_l)
    new_sgu_v_sample = jnp.stack(vr_s_l)
    new_ffn_conv_sample = jnp.stack(cv_s_l)
    return (y_p, y_s, new_wkv_prompt, new_shift_prompt, new_mem_k_prompt, new_mem_v_prompt, new_ffn_conv_prompt,
            new_wkv_sample, new_shift_sample, new_sgu_v_sample, new_ffn_conv_sample)
```

```cpp
#include <hip/hip_runtime.h>
#include <hip/hip_cooperative_groups.h>
#include <cstdio>
namespace cg = cooperative_groups;

#define LAS __attribute__((address_space(3)))
typedef unsigned short bf16_t;
typedef short bf16x8 __attribute__((ext_vector_type(8)));
typedef float f32x4 __attribute__((ext_vector_type(4)));
typedef float f32x2 __attribute__((ext_vector_type(2)));

constexpr int NP = 8192, NTOK = 9216, NSH = 3328, F2 = 11264, DFF = 5632;
constexpr int LDS_BYTES = 131072;
constexpr int NPHASE = 11;

constexpr size_t O_Y = 0, O_WKVP = 18874368, O_SHP = 19136512, O_MK = 19149824, O_MV = 20198400, O_CVP = 21246976,
                 O_WKVS = 21337088, O_SHS = 29725696, O_SGUV = 30151680, O_CVS = 31200256;
constexpr size_t OFF_WBR = 0, OFF_WOUT = OFF_WBR + 12582912, OFF_WUP = OFF_WOUT + 8388608, OFF_WDOWN = OFF_WUP + 46137344,
                 OFF_WSB = OFF_WDOWN + 23068672, OFF_MKB = OFF_WSB + 262144, OFF_MVT = OFF_MKB + 2097152, OFF_LNST = OFF_MVT + 2097152,
                 OFF_BAR = OFF_LNST + 98304,     OFF_WLR = OFF_LNST + 131072, OFF_R2 = OFF_WLR + 524288, SZ_R2 = 264241152, OFF_R1 = OFF_R2 + SZ_R2, SZ_R1 = 122683392, OFF_R3 = OFF_R1 + SZ_R1,
                 SZ_R3 = 188743680, OFF_WMEM = OFF_R3 + SZ_R3, OFF_MN = OFF_WMEM + 8388608, WS_END = OFF_MN + 4194304;
constexpr size_t OFF_WIN = OFF_R2, OFF_XN = OFF_WIN + 51380224;
constexpr size_t OFF_PREP = OFF_R2;
constexpr size_t OFF_ACC32 = OFF_R2, OFF_MIXSUM = OFF_R2 + 75497472, OFF_MIX = OFF_R2 + 113246208;
constexpr size_t OFF_PART = OFF_R2, OFF_UP = OFF_R2, OFF_F = OFF_R3 + 104857600;
constexpr size_t OFF_RW = OFF_R1, OFF_BR = OFF_R1, OFF_H = OFF_R1, OFF_HN = OFF_R1 + 75497472;
constexpr size_t OFF_U = OFF_R3, OFF_GV = OFF_U + 18874368, OFF_Q = OFF_GV + 37748736, OFF_GT = OFF_Q + 18874368, OFF_ACT = OFF_R3;

struct P {
    const float *x_p, *x_s, *mem_p, *st_wkv, *st_shift, *ck, *cv, *st_conv;
    const float *g_pre_mix, *w_in, *mu, *w0, *w_decay, *a0, *w_aaa, *w_gate, *k_k, *k_a, *r_k, *lnx_w, *lnx_b, *sgu_g, *sgu_b, *w_s, *b_s,
        *g_mem, *w_mem_k, *w_mem_v, *w_branch, *w_out, *g_post_mix, *g_pre_ffn, *w_up, *conv_w, *conv_b, *w_down, *g_post_ffn;
    float* out;
    unsigned char* ws;
    long long ph_lo, ph_hi, rep_mask, pad_;
};

typedef __bf16 bf16x2v __attribute__((ext_vector_type(2)));
__device__ __forceinline__ unsigned cvt_pk_bf16(float lo, float hi) { const f32x2 v = {lo, hi}; const bf16x2v b = __builtin_convertvector(v, bf16x2v); return __builtin_bit_cast(unsigned, b); }
__device__ __forceinline__ bf16_t f2bf(float f) { return (bf16_t)(cvt_pk_bf16(f, 0.f) & 0xffffu); }
__device__ __forceinline__ float bf2f(bf16_t b) { return __uint_as_float(((unsigned)b) << 16); }
__device__ __forceinline__ float bflo(unsigned u) { return __uint_as_float(u << 16); }
__device__ __forceinline__ float bfhi(unsigned u) { return __uint_as_float(u & 0xffff0000u); }
__device__ __forceinline__ float wsum(float v) {
#pragma unroll
    for (int o = 32; o; o >>= 1) v += __shfl_xor(v, o);
    return v;
}
__device__ __forceinline__ float wmaxf(float v) {
#pragma unroll
    for (int o = 32; o; o >>= 1) v = fmaxf(v, __shfl_xor(v, o));
    return v;
}
__device__ __forceinline__ float hsum32(float v) {
#pragma unroll
    for (int o = 16; o; o >>= 1) v += __shfl_xor(v, o);
    return v;
}
__device__ __forceinline__ float gelu_t(float x) {
    const float z = 0.7978845608f * (x + 0.044715f * x * x * x);
    const float e = __expf(2.f * z);
    const float t = 1.f - 2.f / (e + 1.f);
    return 0.5f * x * (1.f + t);
}
__device__ __forceinline__ float sigm(float x) { return 1.f / (1.f + __expf(-x)); }
__device__ __forceinline__ float dpp_x1(float v) { return __int_as_float(__builtin_amdgcn_mov_dpp(__float_as_int(v), 0xB1, 0xF, 0xF, true)); }
__device__ __forceinline__ float dpp_x2(float v) { return __int_as_float(__builtin_amdgcn_mov_dpp(__float_as_int(v), 0x4E, 0xF, 0xF, true)); }
__device__ __forceinline__ float dpp_hm(float v) { return __int_as_float(__builtin_amdgcn_mov_dpp(__float_as_int(v), 0x141, 0xF, 0xF, true)); }
__device__ __forceinline__ float red8(float v) { v += dpp_x1(v); v += dpp_x2(v); v += dpp_hm(v); return v; }

namespace pg8 {
constexpr int BM = 256, BK = 64, HALF = 128, HTB = HALF * BK * 2, NXCD = 8, WGM = 8;
__device__ __forceinline__ int lds_byte(int r, int c) { const int st = (r >> 4) * 2 + (c >> 5), rr = r & 15, cc = c & 31, ob = rr * 64 + cc * 2; return st * 1024 + (ob ^ (((ob >> 9) & 1) << 5)); }
__device__ __forceinline__ void stage_rc(int b, int& R, int& C) { const int st = b / 1024, sb = b % 1024, swz = sb ^ (((sb >> 9) & 1) << 5); R = (st >> 1) * 16 + swz / 64; C = (st & 1) * 32 + (swz % 64) / 2; }
__device__ __forceinline__ int perm32(int rho) { const int n = rho >> 4, i = rho & 15; return 8 * (i >> 2) + 4 * n + (i & 3); }
struct Unit { int pm, pn, k0, nt, part; };
struct Gemm { const bf16_t* A; const bf16_t* Bt; int M, N, K; };
__device__ __forceinline__ void tile_remap(int L, int nM, int nN, int& pm, int& pn) {
    const int nwg = nM * nN; int wgid = L;
    { const int q = nwg / NXCD, r = nwg % NXCD, xcd = wgid % NXCD, off = wgid / NXCD; wgid = (xcd < r ? xcd * (q + 1) : r * (q + 1) + (xcd - r) * q) + off; }
    const int nig = WGM * nN, gid = wgid / nig, fm = gid * WGM, gsz = (nM - fm) < WGM ? (nM - fm) : WGM;
    pm = fm + ((wgid % nig) % gsz); pn = (wgid % nig) / gsz;
}
struct StaticOrder {
    int nM, nN, nwg, G, c, ntk;
    __device__ void init(int M, int N, int K, int G_, int c_) { nM = M / BM; nN = N / BM; nwg = nM * nN; G = G_; c = c_; ntk = K / BK; }
    __device__ bool next(int i, Unit& u) const {
        const long L = (long)i * G + c; if (L >= nwg) return false;
        tile_remap((int)L, nM, nN, u.pm, u.pn); u.k0 = 0; u.nt = ntk; u.part = 0; return true;
    }
};
struct TailSplitOrder {
    int c, ntk;
    __device__ bool next(int i, Unit& u) const {
        if (i == 0) { tile_remap(c, 36, 8, u.pm, u.pn); u.k0 = 0; u.nt = ntk; u.part = 0; return true; }
        if (i > 1) return false;
        const int tt = c >> 3, sl = c & 7, pairs = ntk >> 1, bp = pairs >> 3, rp = pairs & 7;
        tile_remap(256 + tt, 36, 8, u.pm, u.pn);
        const int np = bp + (sl < rp ? 1 : 0), sp = sl * bp + (sl < rp ? sl : rp);
        u.k0 = sp * 2 * BK; u.nt = np * 2; u.part = 1 + sl * 32 + tt; return true;
    }
};
struct BranchOrder {
    int G, c;
    __device__ bool next(int i, Unit& u) const {
        if (i < 3) { int pm, pn; tile_remap(c, 36, 8, pm, pn); u.pm = i * 36 + pm; u.pn = i * 8 + pn; u.k0 = 0; u.nt = 16; u.part = 0; return true; }
        if (i > 3 || c >= 192) return false;
        const int tt = c / 6, s6 = c - tt * 6, n = s6 >> 1, hf = s6 & 1;
        int pm, pn; tile_remap(256 + tt, 36, 8, pm, pn); u.pm = n * 36 + pm; u.pn = n * 8 + pn; u.k0 = hf * 512; u.nt = 8; u.part = 1 + s6 * 32 + tt; return true;
    }
};

template <class Epi, class Sched>
__device__ __forceinline__ void gemm_phase(LAS unsigned char* lds, const Gemm g, const Sched& S, const Epi& E) {
    const int tid = threadIdx.x, wid = __builtin_amdgcn_readfirstlane(tid >> 6), lane = tid & 63, wr = wid >> 2, wc = wid & 3, fr = lane & 15, fq = lane >> 4;
    int K = g.K; asm volatile("" : "+s"(K));
    unsigned voffA[2], voffB[2];
#pragma unroll
    for (int i = 0; i < 2; ++i) { int R, C; stage_rc(tid * 16 + i * 8192, R, C); const int Rb = Epi::PERM ? ((R & ~31) + perm32(R & 31)) : R; voffA[i] = (unsigned)(R * K + C) * 2u; voffB[i] = (unsigned)(Rb * K + C) * 2u; }
    const size_t kstep = (size_t)(BK * 2);
    const size_t hstep = (size_t)HALF * K * 2;
    const size_t tstep = 2 * hstep;
    const unsigned ldsw = (unsigned)wid * 1024u;
    const int aoff = lds_byte(wr * 64 + fr, fq * 8), boff = lds_byte(wc * 32 + fr, fq * 8);
#define PG8_SA(b, h) (((b) * 2 + (h)) * HTB)
#define PG8_SB(b, h) ((4 + (b) * 2 + (h)) * HTB)
#define PG8_STAGE(bufoff, gbase, voff) do { _Pragma("unroll") for (int _i = 0; _i < 2; ++_i) \
        __builtin_amdgcn_global_load_lds((const unsigned*)((const char*)(gbase) + (voff)[_i]), (LAS unsigned*)(lds + (bufoff) + ldsw + _i * 8192), 16, 0, 0); } while (0)
#define PG8_LDA(dst, b, h) do { _Pragma("unroll") for (int m = 0; m < 4; ++m) _Pragma("unroll") for (int k = 0; k < 2; ++k) dst[m][k] = *(const LAS bf16x8*)(lds + PG8_SA(b, h) + aoff + m * 2048 + k * 1024); } while (0)
#define PG8_LDB(dst, b, h) do { _Pragma("unroll") for (int n = 0; n < 2; ++n) _Pragma("unroll") for (int k = 0; k < 2; ++k) dst[n][k] = *(const LAS bf16x8*)(lds + PG8_SB(b, h) + boff + n * 2048 + k * 1024); } while (0)
#define PG8_MMA(ai, bj, At, Bt) do { __builtin_amdgcn_s_setprio(1); _Pragma("unroll") for (int m = 0; m < 4; ++m) _Pragma("unroll") for (int n = 0; n < 2; ++n) _Pragma("unroll") for (int k = 0; k < 2; ++k) \
        acc[ai][bj][m][n] = __builtin_amdgcn_mfma_f32_16x16x32_bf16(Bt[n][k], At[m][k], acc[ai][bj][m][n], 0, 0, 0); __builtin_amdgcn_s_setprio(0); } while (0)
#define PG8_WAIT_V(n) asm volatile("s_waitcnt vmcnt(" #n ")" ::: "memory")
#define PG8_WAIT_L(n) asm volatile("s_waitcnt lgkmcnt(" #n ")" ::: "memory")
#define PG8_BAR __builtin_amdgcn_s_barrier()
#define PG8_SCHED __builtin_amdgcn_sched_barrier(0)
    Unit cur, nxt; int ui = 0;
    if (!S.next(0, cur)) return;
    f32x4 acc[2][2][4][2];
#pragma unroll
    for (int a = 0; a < 2; ++a)
#pragma unroll
        for (int b = 0; b < 2; ++b)
#pragma unroll
            for (int m = 0; m < 4; ++m)
#pragma unroll
                for (int n = 0; n < 2; ++n) acc[a][b][m][n] = (f32x4){0.f, 0.f, 0.f, 0.f};
    bf16x8 At[4][2], B0[2][2], B1[2][2];
    const char* cA = (const char*)g.A + (size_t)cur.pm * tstep + (size_t)cur.k0 * 2; const char* cB = (const char*)g.Bt + (size_t)cur.pn * tstep + (size_t)cur.k0 * 2;
    PG8_STAGE(PG8_SB(0, 0), cB, voffB); PG8_STAGE(PG8_SA(0, 0), cA, voffA); PG8_STAGE(PG8_SB(0, 1), cB + hstep, voffB); PG8_STAGE(PG8_SA(0, 1), cA + hstep, voffA);
    if (wr == 1) PG8_BAR;
    PG8_WAIT_V(4); PG8_BAR;
    PG8_STAGE(PG8_SB(1, 0), cB + kstep, voffB); PG8_STAGE(PG8_SA(1, 0), cA + kstep, voffA); PG8_STAGE(PG8_SB(1, 1), cB + hstep + kstep, voffB);
    PG8_WAIT_V(6); PG8_BAR;
    for (;;) {
        const bool has_next = S.next(ui + 1, nxt);
        const char* nA = has_next ? (const char*)g.A + (size_t)nxt.pm * tstep + (size_t)nxt.k0 * 2 : cA; const char* nB = has_next ? (const char*)g.Bt + (size_t)nxt.pn * tstep + (size_t)nxt.k0 * 2 : cB;
        const int nt = cur.nt;
        for (int t = 0; t < nt; t += 2) {
            const bool last = (t == nt - 2);
            const char* a1 = cA + (size_t)(t + 1) * kstep;
            const char* a2 = last ? nA : cA + (size_t)(t + 2) * kstep; const char* b2 = last ? nB : cB + (size_t)(t + 2) * kstep;
            const char* a3 = a2 + kstep; const char* b3 = b2 + kstep;
            PG8_LDB(B0, 0, 0); PG8_SCHED; PG8_LDA(At, 0, 0); PG8_STAGE(PG8_SA(1, 1), a1 + hstep, voffA);
            PG8_WAIT_L(8); PG8_BAR; PG8_WAIT_L(0); PG8_MMA(0, 0, At, B0); PG8_BAR; PG8_SCHED;
            PG8_LDB(B1, 0, 1); PG8_STAGE(PG8_SB(0, 0), b2, voffB);
            PG8_BAR; PG8_WAIT_L(0); PG8_MMA(0, 1, At, B1); PG8_BAR;
            PG8_LDA(At, 0, 1); PG8_STAGE(PG8_SA(0, 0), a2, voffA);
            PG8_BAR; PG8_WAIT_L(0); PG8_MMA(1, 0, At, B0); PG8_BAR; PG8_SCHED;
            PG8_STAGE(PG8_SB(0, 1), b2 + hstep, voffB);
            PG8_WAIT_V(6); PG8_BAR; PG8_MMA(1, 1, At, B1); PG8_BAR;
            PG8_LDB(B0, 1, 0); PG8_SCHED; PG8_LDA(At, 1, 0); PG8_STAGE(PG8_SA(0, 1), a2 + hstep, voffA);
            PG8_WAIT_L(8); PG8_BAR; PG8_WAIT_L(0); PG8_MMA(0, 0, At, B0); PG8_BAR; PG8_SCHED;
            PG8_LDB(B1, 1, 1); PG8_STAGE(PG8_SB(1, 0), b3, voffB);
            PG8_BAR; PG8_WAIT_L(0); PG8_MMA(0, 1, At, B1); PG8_BAR;
            PG8_LDA(At, 1, 1); PG8_STAGE(PG8_SA(1, 0), a3, voffA);
            PG8_BAR; PG8_WAIT_L(0); PG8_MMA(1, 0, At, B0); PG8_BAR; PG8_SCHED;
            PG8_STAGE(PG8_SB(1, 1), b3 + hstep, voffB);
            PG8_WAIT_V(6); PG8_BAR; PG8_MMA(1, 1, At, B1); PG8_BAR;
        }
        E(acc, cur, wr, wc, fr, fq);
        if (!has_next) break;
        if (!E.keep(cur)) {
#pragma unroll
        for (int a = 0; a < 2; ++a)
#pragma unroll
            for (int b = 0; b < 2; ++b)
#pragma unroll
                for (int m = 0; m < 4; ++m)
#pragma unroll
                    for (int n = 0; n < 2; ++n) acc[a][b][m][n] = (f32x4){0.f, 0.f, 0.f, 0.f};
        }
        cur = nxt; cA = nA; cB = nB; ++ui;
    }
    PG8_WAIT_V(0);
    if (wr == 0) PG8_BAR;
    PG8_BAR;
#undef PG8_SA
#undef PG8_SB
#undef PG8_STAGE
#undef PG8_LDA
#undef PG8_LDB
#undef PG8_MMA
#undef PG8_WAIT_V
#undef PG8_WAIT_L
#undef PG8_BAR
#undef PG8_SCHED
}
}
using pg8::Unit;

__device__ __forceinline__ void st_bf16x4(bf16_t* dst, f32x4 v) { uint2 o; o.x = cvt_pk_bf16(v[0], v[1]); o.y = cvt_pk_bf16(v[2], v[3]); *(uint2*)dst = o; }

struct EpiProj {
    static constexpr bool PERM = true;
    float* RW; bf16_t* U; float* GV; bf16_t* Q; bf16_t* GT; float* out;
    __device__ __forceinline__ bool keep(const Unit&) const { return false; }
    __device__ __forceinline__ void operator()(f32x4 (&acc)[2][2][4][2], const Unit& u, int wr, int wc, int fr, int fq) const {
        const int pn = u.pn, row0 = u.pm * 256 + wr * 64 + fr, cl0 = wc * 32 + 8 * fq;
#pragma unroll
        for (int ai = 0; ai < 2; ++ai)
#pragma unroll
            for (int m = 0; m < 4; ++m) {
                const int row = row0 + 128 * ai + 16 * m;
                if (pn < 13) {
                    float* dst = RW + (size_t)row * NSH + pn * 256 + cl0;
                    float* sh = nullptr;
                    if (row < NP) { if ((row & 2047) == 2047) sh = out + O_SHP + (size_t)(row >> 11) * NSH; }
                    else { const int q = row - NP; if ((q & 7) == 7) sh = out + O_SHS + (size_t)(q >> 3) * NSH; }
#pragma unroll
                    for (int bj = 0; bj < 2; ++bj)
#pragma unroll
                        for (int n = 0; n < 2; ++n) {
                            *(f32x4*)(dst + 128 * bj + 4 * n) = acc[ai][bj][m][n];
                            if (sh) *(f32x4*)(sh + pn * 256 + cl0 + 128 * bj + 4 * n) = acc[ai][bj][m][n];
                        }
                } else if (pn >= 17 && pn < 21) {
                    float* dst = GV + (size_t)row * 1024 + (pn - 17) * 256 + cl0;
#pragma unroll
                    for (int bj = 0; bj < 2; ++bj)
#pragma unroll
                        for (int n = 0; n < 2; ++n) { f32x4 v = acc[ai][bj][m][n]; for (int j = 0; j < 4; ++j) v[j] = gelu_t(v[j]); *(f32x4*)(dst + 128 * bj + 4 * n) = v; }
                } else if (pn < 17) {
                    bf16_t* dst = U + (size_t)row * 1024 + (pn - 13) * 256 + cl0;
#pragma unroll
                    for (int bj = 0; bj < 2; ++bj) {
                        f32x4 v0 = acc[ai][bj][m][0], v1 = acc[ai][bj][m][1];
                        for (int j = 0; j < 4; ++j) { v0[j] = gelu_t(v0[j]); v1[j] = gelu_t(v1[j]); }
                        uint4 o; o.x = cvt_pk_bf16(v0[0], v0[1]); o.y = cvt_pk_bf16(v0[2], v0[3]); o.z = cvt_pk_bf16(v1[0], v1[1]); o.w = cvt_pk_bf16(v1[2], v1[3]);
                        *(uint4*)(dst + 128 * bj) = o;
                    }
                } else if (pn < 25) {
                    bf16_t* dst = Q + (size_t)row * 1024 + (pn - 21) * 256 + cl0;
#pragma unroll
                    for (int bj = 0; bj < 2; ++bj) {
                        const f32x4 v0 = acc[ai][bj][m][0], v1 = acc[ai][bj][m][1];
                        uint4 o; o.x = cvt_pk_bf16(v0[0], v0[1]); o.y = cvt_pk_bf16(v0[2], v0[3]); o.z = cvt_pk_bf16(v1[0], v1[1]); o.w = cvt_pk_bf16(v1[2], v1[3]);
                        *(uint4*)(dst + 128 * bj) = o;
                    }
                } else {
                    bf16_t* dst = GT + (size_t)row * 6144 + (pn - 25) * 256 + cl0;
#pragma unroll
                    for (int bj = 0; bj < 2; ++bj) {
                        f32x4 v0 = acc[ai][bj][m][0], v1 = acc[ai][bj][m][1];
                        for (int j = 0; j < 4; ++j) { v0[j] = sigm(v0[j]); v1[j] = sigm(v1[j]); }
                        uint4 o; o.x = cvt_pk_bf16(v0[0], v0[1]); o.y = cvt_pk_bf16(v0[2], v0[3]); o.z = cvt_pk_bf16(v1[0], v1[1]); o.w = cvt_pk_bf16(v1[2], v1[3]);
                        *(uint4*)(dst + 128 * bj) = o;
                    }
                }
            }
    }
};
struct EpiMem {
    static constexpr bool PERM = false;
    float* out; bf16_t* MKB; bf16_t* MVT;
    __device__ __forceinline__ bool keep(const Unit&) const { return false; }
    __device__ __forceinline__ void operator()(f32x4 (&acc)[2][2][4][2], const Unit& u, int wr, int wc, int fr, int fq) const {
        const int pn = u.pn, row0 = u.pm * 256 + wr * 64 + fr, cl0 = wc * 32 + 4 * fq;
#pragma unroll
        for (int ai = 0; ai < 2; ++ai)
#pragma unroll
            for (int m = 0; m < 4; ++m) {
                const int row = row0 + 128 * ai + 16 * m;
#pragma unroll
                for (int bj = 0; bj < 2; ++bj)
#pragma unroll
                    for (int n = 0; n < 2; ++n) {
                        const f32x4 v = acc[ai][bj][m][n];
                        if (pn < 4) {
                            const size_t idx = (size_t)row * 1024 + pn * 256 + cl0 + 128 * bj + 16 * n;
                            *(f32x4*)(out + O_MK + idx) = v; st_bf16x4(MKB + idx, v);
                        } else {
                            const int col = (pn - 4) * 256 + cl0 + 128 * bj + 16 * n;
                            *(f32x4*)(out + O_MV + (size_t)row * 1024 + col) = v;
                            const int b = row >> 8, mm = row & 255, h = col >> 8, d = col & 255;
                            bf16_t* t = MVT + ((size_t)((b * 4 + h) * 256 + d)) * 256 + mm;
                            for (int j = 0; j < 4; ++j) t[j * 256] = f2bf(v[j]);
                        }
                    }
            }
    }
};
struct EpiBranch {
    static constexpr bool PERM = true;
    const bf16_t* GT; bf16_t* MIXSUM;
    float* PART;
    __device__ __forceinline__ bool keep(const Unit& u) const { return !u.part && (u.pm / 36) < 2; }
    __device__ __forceinline__ void operator()(f32x4 (&acc)[2][2][4][2], const Unit& u, int wr, int wc, int fr, int fq) const {
        const int nb = u.pm / 36, pm = u.pm - nb * 36, pn = u.pn - nb * 8;
        const int row0 = pm * 256 + wr * 64 + fr, col0 = pn * 256 + wc * 32 + 8 * fq;
        const bool chain = nb < 2 && !u.part;
#pragma unroll
        for (int am = 0; am < 4; ++am) {
            const int ai = am >> 1, mb = (am & 1) * 2;
            uint4 ga[4][2], gb[4][2];
#pragma unroll
            for (int m = mb; m < mb + 2; ++m) {
                const bf16_t* gp = GT + (size_t)(row0 + 128 * ai + 16 * m) * 6144 + nb * 2048 + col0;
#pragma unroll
                for (int bj = 0; bj < 2; ++bj) { ga[m][bj] = *(const uint4*)(gp + 128 * bj); gb[m][bj] = chain ? *(const uint4*)(gp + 2048 + 128 * bj) : ga[m][bj]; }
            }
#pragma unroll
            for (int m = mb; m < mb + 2; ++m) {
                const int row = row0 + 128 * ai + 16 * m;
#pragma unroll
                for (int bj = 0; bj < 2; ++bj) {
                    f32x4 v0 = acc[ai][bj][m][0], v1 = acc[ai][bj][m][1];
                    const uint4 A = ga[m][bj], B = gb[m][bj];
                    if (chain) {
                        v0[0] *= bflo(A.x) * __builtin_amdgcn_rcpf(bflo(B.x)); v0[1] *= bfhi(A.x) * __builtin_amdgcn_rcpf(bfhi(B.x));
                        v0[2] *= bflo(A.y) * __builtin_amdgcn_rcpf(bflo(B.y)); v0[3] *= bfhi(A.y) * __builtin_amdgcn_rcpf(bfhi(B.y));
                        v1[0] *= bflo(A.z) * __builtin_amdgcn_rcpf(bflo(B.z)); v1[1] *= bfhi(A.z) * __builtin_amdgcn_rcpf(bfhi(B.z));
                        v1[2] *= bflo(A.w) * __builtin_amdgcn_rcpf(bflo(B.w)); v1[3] *= bfhi(A.w) * __builtin_amdgcn_rcpf(bfhi(B.w));
                        acc[ai][bj][m][0] = v0; acc[ai][bj][m][1] = v1;
                    } else {
                        v0[0] *= bflo(A.x); v0[1] *= bfhi(A.x); v0[2] *= bflo(A.y); v0[3] *= bfhi(A.y);
                        v1[0] *= bflo(A.z); v1[1] *= bfhi(A.z); v1[2] *= bflo(A.w); v1[3] *= bfhi(A.w);
                        if (u.part) {
                            float* q = PART + ((size_t)(u.part - 1) * 256 + (wr * 64 + fr + 128 * ai + 16 * m)) * 256 + wc * 32 + 8 * fq + 128 * bj;
                            *(f32x4*)q = v0; *(f32x4*)(q + 4) = v1;
                        } else {
                            uint4 o; o.x = cvt_pk_bf16(v0[0], v0[1]); o.y = cvt_pk_bf16(v0[2], v0[3]); o.z = cvt_pk_bf16(v1[0], v1[1]); o.w = cvt_pk_bf16(v1[2], v1[3]);
                            *(uint4*)(MIXSUM + (size_t)row * 2048 + col0 + 128 * bj) = o;
                        }
                    }
                }
            }
        }
    }
};
struct EpiF32 {
    static constexpr bool PERM = true;
    bf16_t* C16; int ldc; float* PART;
    __device__ __forceinline__ bool keep(const Unit&) const { return false; }
    __device__ __forceinline__ void operator()(f32x4 (&acc)[2][2][4][2], const Unit& u, int wr, int wc, int fr, int fq) const {
        if (u.part) {
            float* base = PART + (size_t)(u.part - 1) * 65536 + (size_t)(wr * 64 + fr) * 256 + wc * 32 + 8 * fq;
#pragma unroll
            for (int ai = 0; ai < 2; ++ai)
#pragma unroll
                for (int m = 0; m < 4; ++m) {
                    float* rowp = base + (size_t)(128 * ai + 16 * m) * 256;
#pragma unroll
                    for (int bj = 0; bj < 2; ++bj) { *(f32x4*)(rowp + 128 * bj) = acc[ai][bj][m][0]; *(f32x4*)(rowp + 128 * bj + 4) = acc[ai][bj][m][1]; }
                }
        } else {
            bf16_t* base = C16 + (size_t)(u.pm * 256 + wr * 64 + fr) * ldc + u.pn * 256 + wc * 32 + 8 * fq;
#pragma unroll
            for (int ai = 0; ai < 2; ++ai)
#pragma unroll
                for (int m = 0; m < 4; ++m) {
                    bf16_t* rowp = base + (size_t)(128 * ai + 16 * m) * ldc;
#pragma unroll
                    for (int bj = 0; bj < 2; ++bj) {
                        const f32x4 v0 = acc[ai][bj][m][0], v1 = acc[ai][bj][m][1];
                        uint4 o; o.x = cvt_pk_bf16(v0[0], v0[1]); o.y = cvt_pk_bf16(v0[2], v0[3]); o.z = cvt_pk_bf16(v1[0], v1[1]); o.w = cvt_pk_bf16(v1[2], v1[3]);
                        *(uint4*)(rowp + 128 * bj) = o;
                    }
                }
        }
    }
};
__device__ void reduce_branch_tail(const float* PART, bf16_t* MIXSUM) {
    const int lane = threadIdx.x & 63, gw = blockIdx.x * 8 + (threadIdx.x >> 6), nw = gridDim.x * 8;
    for (int r = gw; r < 32 * 256; r += nw) {
        const int tt = r >> 8, rr = r & 255;
        int pm, pn; pg8::tile_remap(256 + tt, 36, 8, pm, pn);
        f32x4 a = {0.f, 0.f, 0.f, 0.f};
#pragma unroll
        for (int s6 = 0; s6 < 6; ++s6) a += *(const f32x4*)(PART + ((size_t)(s6 * 32 + tt) * 256 + rr) * 256 + lane * 4);
        st_bf16x4(MIXSUM + (size_t)(pm * 256 + rr) * 2048 + pn * 256 + lane * 4, a);
    }
}
__device__ __forceinline__ void build_tailmap(int* tm) {
    for (int i = threadIdx.x; i < 288; i += 512) tm[i] = -1;
    __syncthreads();
    if (threadIdx.x < 32) { int pm, pn; pg8::tile_remap(256 + threadIdx.x, 36, 8, pm, pn); tm[pm * 8 + pn] = threadIdx.x; }
    __syncthreads();
}
__device__ __forceinline__ float4 ld4bf(const bf16_t* q) { const uint2 u = *(const uint2*)q; return make_float4(bflo(u.x), bfhi(u.x), bflo(u.y), bfhi(u.y)); }
__device__ __forceinline__ float4 sum_parts(const float* PART, int tt, int r255, int lane) {
    float4 a = make_float4(0.f, 0.f, 0.f, 0.f);
#pragma unroll
    for (int sl = 0; sl < 8; ++sl) { const float4 x = *(const float4*)(PART + ((size_t)(sl * 32 + tt) * 256 + r255) * 256 + lane * 4); a.x += x.x; a.y += x.y; a.z += x.z; a.w += x.w; }
    return a;
}
struct EpiUp {
    static constexpr bool PERM = true;
    bf16_t* UP; float* out;
    __device__ __forceinline__ bool keep(const Unit&) const { return false; }
    __device__ __forceinline__ void operator()(f32x4 (&acc)[2][2][4][2], const Unit& u, int wr, int wc, int fr, int fq) const {
        const int row0 = u.pm * 256 + wr * 64 + fr, col0 = u.pn * 256 + wc * 32 + 8 * fq;
#pragma unroll
        for (int ai = 0; ai < 2; ++ai)
#pragma unroll
            for (int m = 0; m < 4; ++m) {
                const int row = row0 + 128 * ai + 16 * m;
                float* cs = nullptr;
                if (row < NP) { const int t = row & 2047; if (t >= 2046) cs = out + O_CVP + (size_t)((row >> 11) * 2 + (t - 2046)) * F2; }
                else { const int q = row - NP, t = q & 7; if (t >= 6) cs = out + O_CVS + (size_t)((q >> 3) * 2 + (t - 6)) * F2; }
                bf16_t* rowp = UP + (size_t)row * F2 + col0;
#pragma unroll
                for (int bj = 0; bj < 2; ++bj) {
                    const f32x4 v0 = acc[ai][bj][m][0], v1 = acc[ai][bj][m][1];
                    uint4 o; o.x = cvt_pk_bf16(v0[0], v0[1]); o.y = cvt_pk_bf16(v0[2], v0[3]); o.z = cvt_pk_bf16(v1[0], v1[1]); o.w = cvt_pk_bf16(v1[2], v1[3]);
                    *(uint4*)(rowp + 128 * bj) = o;
                    if (cs) { *(f32x4*)(cs + col0 + 128 * bj) = v0; *(f32x4*)(cs + col0 + 128 * bj + 4) = v1; }
                }
            }
    }
};

struct TcSeg { const float* src; bf16_t* dst; int K, N, tk, tn; };
__device__ __forceinline__ void tconv_seg(const P& p, int gi, TcSeg& g) {
    unsigned char* ws = p.ws; int l;
    if (gi < 6272) { g.src = p.w_in; g.dst = (bf16_t*)(ws + OFF_WIN); g.K = 2048; g.N = 12544; l = gi; }
    else if (gi < 6784) { g.src = p.w_mem_k; g.dst = (bf16_t*)(ws + OFF_WMEM); g.K = 2048; g.N = 1024; l = gi - 6272; }
    else if (gi < 7296) { g.src = p.w_mem_v; g.dst = (bf16_t*)(ws + OFF_WMEM) + (size_t)1024 * 2048; g.K = 2048; g.N = 1024; l = gi - 6784; }
    else if (gi < 8832) { const int nb = (gi - 7296) / 512; g.src = p.w_branch + (size_t)nb * 1024 * 2048; g.dst = (bf16_t*)(ws + OFF_WBR) + (size_t)nb * 2048 * 1024; g.K = 1024; g.N = 2048; l = (gi - 7296) - nb * 512; }
    else if (gi < 9856) { g.src = p.w_out; g.dst = (bf16_t*)(ws + OFF_WOUT); g.K = 2048; g.N = 2048; l = gi - 8832; }
    else if (gi < 15488) { g.src = p.w_up; g.dst = (bf16_t*)(ws + OFF_WUP); g.K = 2048; g.N = F2; l = gi - 9856; }
    else { g.src = p.w_down; g.dst = (bf16_t*)(ws + OFF_WDOWN); g.K = DFF; g.N = 2048; l = gi - 15488; }
    const int ntn = g.N / 64; g.tk = l / ntn; g.tn = l - g.tk * ntn;
}
__device__ __forceinline__ void rms_row_bf16(const float* __restrict__ x, const float* __restrict__ g, bf16_t* __restrict__ o, int lane) {
    float4 v[8]; float ss = 0.f;
#pragma unroll
    for (int i = 0; i < 8; ++i) { v[i] = *(const float4*)(x + (i * 64 + lane) * 4); ss += v[i].x * v[i].x + v[i].y * v[i].y + v[i].z * v[i].z + v[i].w * v[i].w; }
    ss = wsum(ss);
    const float r = rsqrtf(ss * (1.f / 2048.f) + 1e-6f);
#pragma unroll
    for (int i = 0; i < 8; ++i) {
        const float4 gg = *(const float4*)(g + (i * 64 + lane) * 4);
        uint2 pk; pk.x = cvt_pk_bf16(v[i].x * r * gg.x, v[i].y * r * gg.y); pk.y = cvt_pk_bf16(v[i].z * r * gg.z, v[i].w * r * gg.w);
        *(uint2*)(o + (i * 64 + lane) * 4) = pk;
    }
}
__device__ void convert_tiles(const P& p, unsigned char* smem, int gi0, int gi1, int bidx, int nblk) {
    float* tile = (float*)smem;
    const int tid = threadIdx.x, kk0 = tid >> 4, n4 = (tid & 15) * 4, nn = tid >> 3, kc = (tid & 7) * 8;
    int gi = gi0 + bidx;
    if (gi >= gi1) return;
    TcSeg g; tconv_seg(p, gi, g);
    float4 v0 = *(const float4*)(g.src + (size_t)(g.tk * 64 + kk0) * g.N + g.tn * 64 + n4), v1 = *(const float4*)(g.src + (size_t)(g.tk * 64 + kk0 + 32) * g.N + g.tn * 64 + n4);
    for (;;) {
        const int gn = gi + nblk; const bool more = gn < gi1;
        TcSeg h = g; float4 u0 = v0, u1 = v1;
        if (more) { tconv_seg(p, gn, h); u0 = *(const float4*)(h.src + (size_t)(h.tk * 64 + kk0) * h.N + h.tn * 64 + n4); u1 = *(const float4*)(h.src + (size_t)(h.tk * 64 + kk0 + 32) * h.N + h.tn * 64 + n4); }
        { float* t = tile + kk0 * 65 + n4; t[0] = v0.x; t[1] = v0.y; t[2] = v0.z; t[3] = v0.w; t += 32 * 65; t[0] = v1.x; t[1] = v1.y; t[2] = v1.z; t[3] = v1.w; }
        __syncthreads();
        uint4 o;
        o.x = cvt_pk_bf16(tile[(kc + 0) * 65 + nn], tile[(kc + 1) * 65 + nn]);
        o.y = cvt_pk_bf16(tile[(kc + 2) * 65 + nn], tile[(kc + 3) * 65 + nn]);
        o.z = cvt_pk_bf16(tile[(kc + 4) * 65 + nn], tile[(kc + 5) * 65 + nn]);
        o.w = cvt_pk_bf16(tile[(kc + 6) * 65 + nn], tile[(kc + 7) * 65 + nn]);
        *(uint4*)(g.dst + (size_t)(g.tn * 64 + nn) * g.K + g.tk * 64 + kc) = o;
        __syncthreads();
        if (!more) break;
        gi = gn; g = h; v0 = u0; v1 = u1;
    }
}
__device__ void phase0(const P& p, unsigned char* smem) {
    unsigned char* ws = p.ws;
    const int G = gridDim.x;
    convert_tiles(p, smem, 0, 7296, blockIdx.x, G);
    {
        bf16_t* wlr = (bf16_t*)(ws + OFF_WLR);
        for (int i = blockIdx.x * 512 + threadIdx.x; i < 256 * 1024; i += G * 512) {
            const int k = i >> 10, c = i & 1023;
            const float v = k < 64 ? p.w_decay[i] : (k < 128 ? p.w_aaa[i - 64 * 1024] : p.w_gate[i - 128 * 1024]);
            wlr[c * 256 + k] = f2bf(v);
        }
    }
    {
        bf16_t* wsb = (bf16_t*)(ws + OFF_WSB);
        for (int i = blockIdx.x * 512 + threadIdx.x; i < 8 * 128 * 128; i += G * 512) {
            const int s = i & 127, t = (i >> 7) & 127;
            wsb[i] = f2bf(s <= t ? p.w_s[i] : 0.f);
        }
    }
    const int lane = threadIdx.x & 63, wv = threadIdx.x >> 6;
    for (int r = blockIdx.x * 8 + wv; r < NTOK + 1024; r += G * 8) {
        if (r < NTOK) {
            const float* x = r < NP ? p.x_p + (size_t)r * 2048 : p.x_s + (size_t)(r - NP) * 2048;
            rms_row_bf16(x, p.g_pre_mix, (bf16_t*)(ws + OFF_XN) + (size_t)r * 2048, lane);
        } else {
            const int q = r - NTOK;
            rms_row_bf16(p.mem_p + (size_t)q * 2048, p.g_mem, (bf16_t*)(ws + OFF_MN) + (size_t)q * 2048, lane);
        }
    }
}

__device__ __forceinline__ float hsum32d(float v) {
    v += dpp_x1(v); v += dpp_x2(v); v += dpp_hm(v);
    v += __int_as_float(__builtin_amdgcn_mov_dpp(__float_as_int(v), 0x140, 0xF, 0xF, true));
    v += __shfl_xor(v, 16);
    return v;
}
__device__ void phase_prep(const P& p, unsigned char* smem) {
    bf16_t* Ab = (bf16_t*)smem;
    float* lro = (float*)(smem + 8448);
    const float* RW = (const float*)(p.ws + OFF_RW);
    float* PREP = (float*)(p.ws + OFF_PREP);
    const float* GV = (const float*)(p.ws + OFF_GV);
    float* LNST = (float*)(p.ws + OFF_LNST);
    const bf16_t* WLR = (const bf16_t*)(p.ws + OFF_WLR);
    const int tid = threadIdx.x, lane = tid & 63, wv = tid >> 6, fr = lane & 15, kg = lane >> 4;
    for (int kt = 0; kt < 3; ++kt) {
        const int cb_ = blockIdx.x; const int ti = kt == 0 ? cb_ : (kt == 1 ? (cb_ < 224 ? 256 + cb_ : -1) : (cb_ < 96 ? 480 + cb_ : -1));
        if (ti < 0) continue;
        const int row0 = ti * 16;
        {
            const bool smp = row0 >= NP;
            float curA[8], prvA[8];
#pragma unroll
            for (int i = 0; i < 8; ++i) {
                const int e = tid + i * 512, t = e >> 8, col = 3072 + (e & 255), row = row0 + t;
                const bool first = smp ? (((row - NP) & 7) == 0) : ((row & 2047) == 0);
                const float* pp = first ? (smp ? p.st_shift + (size_t)((row - NP) >> 3) * NSH : RW + (size_t)row * NSH) : RW + (size_t)(row - 1) * NSH;
                curA[i] = RW[(size_t)row * NSH + col];
                prvA[i] = pp[col];
                if (first && !smp) prvA[i] = 0.f;
            }
#pragma unroll
            for (int i = 0; i < 8; ++i) {
                const int e = tid + i * 512, t = e >> 8, j = e & 255;
                const float s = curA[i] + p.mu[3072 + j] * (prvA[i] - curA[i]);
                Ab[t * 264 + j] = f2bf(j < 64 ? (1.f - 2.f / (__expf(2.f * s) + 1.f)) : (j < 128 ? s : sigm(s)));
            }
        }
        __syncthreads();
#pragma unroll 1
        for (int half = 0; half < 2; ++half) {
            bf16x8 af[8];
#pragma unroll
            for (int ks = 0; ks < 8; ++ks) af[ks] = *(const bf16x8*)(Ab + fr * 264 + 32 * ks + 8 * kg);
#pragma unroll
            for (int nt = 0; nt < 4; ++nt) {
                const bf16_t* wrow = WLR + (size_t)(512 * half + 64 * wv + 16 * nt + fr) * 256 + 8 * kg;
                bf16x8 bfr[8];
#pragma unroll
                for (int ks = 0; ks < 8; ++ks) bfr[ks] = *(const bf16x8*)(wrow + 32 * ks);
                f32x4 ad = {0.f, 0.f, 0.f, 0.f}, aa = ad, ag = ad;
                ad = __builtin_amdgcn_mfma_f32_16x16x32_bf16(af[0], bfr[0], ad, 0, 0, 0); ad = __builtin_amdgcn_mfma_f32_16x16x32_bf16(af[1], bfr[1], ad, 0, 0, 0);
                aa = __builtin_amdgcn_mfma_f32_16x16x32_bf16(af[2], bfr[2], aa, 0, 0, 0); aa = __builtin_amdgcn_mfma_f32_16x16x32_bf16(af[3], bfr[3], aa, 0, 0, 0);
#pragma unroll
                for (int ks = 4; ks < 8; ++ks) ag = __builtin_amdgcn_mfma_f32_16x16x32_bf16(af[ks], bfr[ks], ag, 0, 0, 0);
#pragma unroll
                for (int i = 0; i < 4; ++i) {
                    float* o = lro + (4 * kg + i) * 1536 + 64 * wv + 16 * nt + fr;
                    o[0] = ad[i]; o[512] = aa[i]; o[1024] = ag[i];
                }
            }
            __syncthreads();
            {
                const int cl = 2 * (tid & 255), c0 = 512 * half + cl, tg = tid >> 8, h = c0 >> 6, cc = c0 & 63;
                const f32x2 mur = *(const f32x2*)(p.mu + c0), muk = *(const f32x2*)(p.mu + 1024 + c0), muv = *(const f32x2*)(p.mu + 2048 + c0);
                const f32x2 w0v = *(const f32x2*)(p.w0 + c0), a0v = *(const f32x2*)(p.a0 + c0), kkv = *(const f32x2*)(p.k_k + c0), kav = *(const f32x2*)(p.k_a + c0);
                f32x2 pr = {0.f, 0.f}, pk = pr, pv = pr;
                {
                    const int row = row0 + 8 * tg; const float* pp = nullptr;
                    if (row < NP) { if (row & 2047) pp = RW + (size_t)(row - 1) * NSH; }
                    else { const int q = row - NP; pp = (q & 7) ? RW + (size_t)(row - 1) * NSH : p.st_shift + (size_t)(q >> 3) * NSH; }
                    if (pp) { pr = *(const f32x2*)(pp + c0); pk = *(const f32x2*)(pp + 1024 + c0); pv = *(const f32x2*)(pp + 2048 + c0); }
                }
                f32x2 crA[8], ckA[8], cvA[8];
#pragma unroll
                for (int tt = 0; tt < 8; ++tt) {
                    const float* rwp = RW + (size_t)(row0 + 8 * tg + tt) * NSH;
                    crA[tt] = *(const f32x2*)(rwp + c0); ckA[tt] = *(const f32x2*)(rwp + 1024 + c0); cvA[tt] = *(const f32x2*)(rwp + 2048 + c0);
                }
#pragma unroll
                for (int tt = 0; tt < 8; ++tt) {
                    const int t = 8 * tg + tt;
                    const f32x2 cr = crA[tt], ck = ckA[tt], cv = cvA[tt];
                    const f32x2 r = cr + mur * (pr - cr), k = ck + muk * (pk - ck), v = cv + muv * (pv - cv);
                    pr = cr; pk = ck; pv = cv;
                    const f32x2 dpv = *(const f32x2*)(lro + t * 1536 + cl), apv = *(const f32x2*)(lro + t * 1536 + 512 + cl), gpv = *(const f32x2*)(lro + t * 1536 + 1024 + cl);
                    f32x2 dec, a;
#pragma unroll
                    for (int e = 0; e < 2; ++e) {
                        const float z = -(w0v[e] + dpv[e]);
                        const float sp = fmaxf(z, 0.f) + __logf(1.f + __expf(-fabsf(z)));
                        dec[e] = __expf(-__expf(-sp - 0.5f));
                        a[e] = 1.f / (1.f + __expf(-(a0v[e] + apv[e])));
                    }
                    const f32x2 kk = k * kkv;
                    const float ss = hsum32d(kk[0] * kk[0] + kk[1] * kk[1]);
                    const float inv = 1.f / fmaxf(sqrtf(ss), 1e-12f);
                    const f32x2 kkn = kk * inv;
                    const f32x2 k2 = k * (1.f + (a - 1.f) * kav);
                    float* dst = PREP + ((size_t)(row0 + t) * 16 + h) * 448 + cc;
                    *(f32x2*)(dst) = r; *(f32x2*)(dst + 64) = dec; *(f32x2*)(dst + 128) = k2; *(f32x2*)(dst + 192) = v;
                    *(f32x2*)(dst + 256) = -kkn; *(f32x2*)(dst + 320) = kkn * a; *(f32x2*)(dst + 384) = gpv;
                }
            }
            __syncthreads();
        }
#pragma unroll
        for (int q2 = 0; q2 < 2; ++q2) {
            const int row = row0 + 2 * wv + q2;
            const float* gr = GV + (size_t)row * 1024;
            float4 x[4]; float sm = 0.f;
#pragma unroll
            for (int i = 0; i < 4; ++i) { x[i] = *(const float4*)(gr + (i * 64 + lane) * 4); sm += x[i].x + x[i].y + x[i].z + x[i].w; }
            const float mean = wsum(sm) * (1.f / 1024.f);
            float q = 0.f;
#pragma unroll
            for (int i = 0; i < 4; ++i) { const float a = x[i].x - mean, b = x[i].y - mean, c = x[i].z - mean, d = x[i].w - mean; q += a * a + b * b + c * c + d * d; }
            const float var = wsum(q) * (1.f / 1024.f);
            if (lane == 0) { LNST[(size_t)row * 2] = mean; LNST[(size_t)row * 2 + 1] = rsqrtf(var + 1e-5f); }
        }
    }
}

__device__ __forceinline__ float sum16d(float v) {
    v += dpp_x1(v); v += dpp_x2(v); v += dpp_hm(v);
    v += __int_as_float(__builtin_amdgcn_mov_dpp(__float_as_int(v), 0x140, 0xF, 0xF, true));
    return v;
}
__device__ void scan_seq(const P& p, unsigned char* smem, int row0, int T, int h, const float* s_in, float* s_out) {
    float* buf = (float*)smem;
    float* ybuf = (float*)(smem + 86016);
    const float* PREP = (const float*)(p.ws + OFF_PREP);
    bf16_t* AOUT = (bf16_t*)(p.ws + OFF_BR);
    const int tid = threadIdx.x, lane = tid & 63, wv = tid >> 6, r8 = lane >> 3, kq = lane & 7, row = (wv & 3) * 8 + r8, rowB = row + 32;
    const bool scanw = wv < 4;
    const int htid = tid & 255, ht = htid >> 4, l16 = htid & 15;
    const int TC = T < 16 ? T : 16, nch = T / TC, nf4 = TC * 112;
    f32x2 S0 = {0.f, 0.f}, S1 = S0, S2 = S0, S3 = S0, T0 = S0, T1 = S0, T2 = S0, T3 = S0;
    if (s_in && scanw) {
        const f32x4 a = *(const f32x4*)(s_in + row * 64 + kq * 8), b = *(const f32x4*)(s_in + row * 64 + kq * 8 + 4); S0 = __builtin_shufflevector(a, a, 0, 1); S1 = __builtin_shufflevector(a, a, 2, 3); S2 = __builtin_shufflevector(b, b, 0, 1); S3 = __builtin_shufflevector(b, b, 2, 3);
        const f32x4 c2 = *(const f32x4*)(s_in + rowB * 64 + kq * 8), d2 = *(const f32x4*)(s_in + rowB * 64 + kq * 8 + 4); T0 = __builtin_shufflevector(c2, c2, 0, 1); T1 = __builtin_shufflevector(c2, c2, 2, 3); T2 = __builtin_shufflevector(d2, d2, 0, 1); T3 = __builtin_shufflevector(d2, d2, 2, 3);
    }
    float4 h0, h1, h2, h3, h4, h5, h6;
#define HPF_LOAD1(dst, i, tokbase) { int idx = htid + (i) * 256; idx = idx < nf4 ? idx : nf4 - 1; const int tk = idx / 112, off = idx - tk * 112; dst = *(const float4*)(PREP + ((size_t)((tokbase) + tk) * 16 + h) * 448 + off * 4); }
#define HPF_STORE1(src, i, base) { const int idx = htid + (i) * 256; if (idx < nf4) *(float4*)((base) + idx * 4) = src; }
#define HPF_LOAD(tokbase) { HPF_LOAD1(h0, 0, tokbase) HPF_LOAD1(h1, 1, tokbase) HPF_LOAD1(h2, 2, tokbase) HPF_LOAD1(h3, 3, tokbase) HPF_LOAD1(h4, 4, tokbase) HPF_LOAD1(h5, 5, tokbase) HPF_LOAD1(h6, 6, tokbase) }
#define HPF_STORE(base) { HPF_STORE1(h0, 0, base) HPF_STORE1(h1, 1, base) HPF_STORE1(h2, 2, base) HPF_STORE1(h3, 3, base) HPF_STORE1(h4, 4, base) HPF_STORE1(h5, 5, base) HPF_STORE1(h6, 6, base) }
    float4 lw4 = make_float4(0.f, 0.f, 0.f, 0.f), lb4 = lw4, rk4 = lw4;
    if (!scanw) {
        HPF_LOAD(row0) HPF_STORE(buf)
        if (nch > 1) HPF_LOAD(row0 + TC)
        lw4 = *(const float4*)(p.lnx_w + h * 64 + 4 * l16); lb4 = *(const float4*)(p.lnx_b + h * 64 + 4 * l16); rk4 = *(const float4*)(p.r_k + h * 64 + 4 * l16);
    }
    __syncthreads();
#define LO2(v) __builtin_shufflevector(v, v, 0, 1)
#define HI2(v) __builtin_shufflevector(v, v, 2, 3)
#define ST_LOAD(X, i) { const int ii_ = (i) < TC ? (i) : TC - 1; const float* b_ = cb + ii_ * 448 + kq * 8; \
            X##w0 = *(const f32x4*)(b_ + 64); X##w1 = *(const f32x4*)(b_ + 68); X##a0 = *(const f32x4*)(b_ + 256); X##a1 = *(const f32x4*)(b_ + 260); \
            X##b0 = *(const f32x4*)(b_ + 320); X##b1 = *(const f32x4*)(b_ + 324); X##k0 = *(const f32x4*)(b_ + 128); X##k1 = *(const f32x4*)(b_ + 132); \
            X##q0 = *(const f32x4*)(b_); X##q1 = *(const f32x4*)(b_ + 4); X##vr = cb[ii_ * 448 + 192 + row]; X##vs = cb[ii_ * 448 + 192 + rowB]; }
#define ST_STEP(X, i) { f32x2 ac_ = S0 * LO2(X##a0); ac_ = S1 * HI2(X##a0) + ac_; ac_ = S2 * LO2(X##a1) + ac_; ac_ = S3 * HI2(X##a1) + ac_; \
            f32x2 bc_ = T0 * LO2(X##a0); bc_ = T1 * HI2(X##a0) + bc_; bc_ = T2 * LO2(X##a1) + bc_; bc_ = T3 * HI2(X##a1) + bc_; \
            const float sa_ = red8(ac_[0] + ac_[1]), sb_ = red8(bc_[0] + bc_[1]); const f32x2 sv_ = {sa_, sa_}, vv_ = {X##vr, X##vr}, sw_ = {sb_, sb_}, vw_ = {X##vs, X##vs}; \
            S0 = S0 * LO2(X##w0) + (sv_ * LO2(X##b0) + vv_ * LO2(X##k0)); S1 = S1 * HI2(X##w0) + (sv_ * HI2(X##b0) + vv_ * HI2(X##k0)); \
            S2 = S2 * LO2(X##w1) + (sv_ * LO2(X##b1) + vv_ * LO2(X##k1)); S3 = S3 * HI2(X##w1) + (sv_ * HI2(X##b1) + vv_ * HI2(X##k1)); \
            T0 = T0 * LO2(X##w0) + (sw_ * LO2(X##b0) + vw_ * LO2(X##k0)); T1 = T1 * HI2(X##w0) + (sw_ * HI2(X##b0) + vw_ * HI2(X##k0)); \
            T2 = T2 * LO2(X##w1) + (sw_ * LO2(X##b1) + vw_ * LO2(X##k1)); T3 = T3 * HI2(X##w1) + (sw_ * HI2(X##b1) + vw_ * HI2(X##k1)); \
            f32x2 ya_ = S0 * LO2(X##q0); ya_ = S1 * HI2(X##q0) + ya_; ya_ = S2 * LO2(X##q1) + ya_; ya_ = S3 * HI2(X##q1) + ya_; \
            f32x2 yb_ = T0 * LO2(X##q0); yb_ = T1 * HI2(X##q0) + yb_; yb_ = T2 * LO2(X##q1) + yb_; yb_ = T3 * HI2(X##q1) + yb_; \
            float y1_ = ya_[0] + ya_[1], y2_ = yb_[0] + yb_[1]; y1_ += dpp_x1(y1_); y2_ += dpp_x1(y2_); y1_ += dpp_x2(y1_); y2_ += dpp_x2(y2_); \
            if ((kq & 3) == 0) { yb[(i) * 128 + row * 2 + (kq >> 2)] = y1_; yb[(i) * 128 + rowB * 2 + (kq >> 2)] = y2_; } }
    for (int c = 0; c < nch; ++c) {
        if (scanw) {
            const float* cb = buf + (c % 3) * (16 * 448);
            float* yb = ybuf + (c & 1) * 2048;
            f32x4 Aw0, Aw1, Aa0, Aa1, Ab0, Ab1, Ak0, Ak1, Aq0, Aq1, Bw0, Bw1, Ba0, Ba1, Bb0, Bb1, Bk0, Bk1, Bq0, Bq1; float Avr, Bvr, Avs, Bvs;
            ST_LOAD(A, 0)
            for (int i = 0; i < TC; i += 2) {
                ST_LOAD(B, i + 1)
                ST_STEP(A, i)
                ST_LOAD(A, i + 2)
                ST_STEP(B, i + 1)
            }
        } else {
            if (c + 1 < nch) { float* nb = buf + ((c + 1) % 3) * (16 * 448); HPF_STORE(nb) }
            if (c + 2 < nch) HPF_LOAD(row0 + (c + 2) * TC)
        }
        if (!scanw && c >= 1) {
#define SCAN_POST(cc) { const float* cbp = buf + ((cc) % 3) * (16 * 448); const float* ybp = ybuf + ((cc) & 1) * 2048; \
            if (ht < TC) { const float* tb = cbp + ht * 448; \
                const float4 pa = *(const float4*)(ybp + ht * 128 + 8 * l16), pb = *(const float4*)(ybp + ht * 128 + 8 * l16 + 4); \
                const float y0 = pa.x + pa.y, y1 = pa.z + pa.w, y2 = pb.x + pb.y, y3 = pb.z + pb.w; \
                const float mean = sum16d((y0 + y1) + (y2 + y3)) * (1.f / 64.f); \
                const float d0 = y0 - mean, d1 = y1 - mean, d2 = y2 - mean, d3 = y3 - mean; \
                const float rs = rsqrtf(sum16d((d0 * d0 + d1 * d1) + (d2 * d2 + d3 * d3)) * (1.f / 64.f) + 64e-5f); \
                const float4 r4 = *(const float4*)(tb + 4 * l16), k4 = *(const float4*)(tb + 128 + 4 * l16), v4 = *(const float4*)(tb + 192 + 4 * l16), g4 = *(const float4*)(tb + 384 + 4 * l16); \
                const float bon = sum16d((r4.x * k4.x * rk4.x + r4.y * k4.y * rk4.y) + (r4.z * k4.z * rk4.z + r4.w * k4.w * rk4.w)); \
                uint2 o; o.x = cvt_pk_bf16((d0 * rs * lw4.x + lb4.x + bon * v4.x) * g4.x, (d1 * rs * lw4.y + lb4.y + bon * v4.y) * g4.y); \
                o.y = cvt_pk_bf16((d2 * rs * lw4.z + lb4.z + bon * v4.z) * g4.z, (d3 * rs * lw4.w + lb4.w + bon * v4.w) * g4.w); \
                *(uint2*)(AOUT + (size_t)(row0 + (cc) * TC + ht) * 1024 + h * 64 + 4 * l16) = o; } }
            SCAN_POST(c - 1)
        }
        __syncthreads();
    }
    if (!scanw) SCAN_POST(nch - 1)
    if (scanw) {
        float4 a, b; a.x = S0[0]; a.y = S0[1]; a.z = S1[0]; a.w = S1[1]; b.x = S2[0]; b.y = S2[1]; b.z = S3[0]; b.w = S3[1];
        *(float4*)(s_out + row * 64 + kq * 8) = a; *(float4*)(s_out + row * 64 + kq * 8 + 4) = b;
        a.x = T0[0]; a.y = T0[1]; a.z = T1[0]; a.w = T1[1]; b.x = T2[0]; b.y = T2[1]; b.z = T3[0]; b.w = T3[1];
        *(float4*)(s_out + rowB * 64 + kq * 8) = a; *(float4*)(s_out + rowB * 64 + kq * 8 + 4) = b;
    }
    __syncthreads();
}

template <bool SAMPLE>
__device__ void attn_item(const P& p, unsigned char* smem, int b, int h, int r0) {
    constexpr int MT = SAMPLE ? 1 : 2;
    float* Sb = (float*)smem;
    bf16_t* Pb = (bf16_t*)(smem + 33280);
    const bf16_t* Q = (const bf16_t*)(p.ws + OFF_Q);
    const bf16_t* MKB = (const bf16_t*)(p.ws + OFF_MKB);
    const bf16_t* MVT = (const bf16_t*)(p.ws + OFF_MVT);
    bf16_t* COUT = (bf16_t*)(p.ws + OFF_BR) + (size_t)2 * NTOK * 1024;
    const int tid = threadIdx.x, lane = tid & 63, wv = tid >> 6, fr = lane & 15, kg = lane >> 4;
    bf16x8 qa[MT][8];
#pragma unroll
    for (int mt = 0; mt < MT; ++mt) {
        const int rq = SAMPLE ? r0 + (fr & 7) : r0 + 16 * mt + fr;
#pragma unroll
        for (int ks = 0; ks < 8; ++ks) qa[mt][ks] = *(const bf16x8*)(Q + (size_t)rq * 1024 + h * 256 + 32 * ks + 8 * kg);
    }
    f32x4 acc[MT][2];
#pragma unroll
    for (int mt = 0; mt < MT; ++mt) { acc[mt][0] = (f32x4){0.f, 0.f, 0.f, 0.f}; acc[mt][1] = acc[mt][0]; }
#pragma unroll
    for (int nt = 0; nt < 2; ++nt) {
        const int mrow = 32 * wv + 16 * nt + fr;
#pragma unroll
        for (int ks = 0; ks < 8; ++ks) {
            bf16x8 bf;
            if (SAMPLE) {
                const float* kp = p.ck + ((size_t)(b * 256 + mrow)) * 1024 + h * 256 + 32 * ks + 8 * kg;
                const float4 x = *(const float4*)kp, y = *(const float4*)(kp + 4);
                union { bf16x8 v; unsigned u[4]; } cvt;
                cvt.u[0] = cvt_pk_bf16(x.x, x.y); cvt.u[1] = cvt_pk_bf16(x.z, x.w); cvt.u[2] = cvt_pk_bf16(y.x, y.y); cvt.u[3] = cvt_pk_bf16(y.z, y.w);
                bf = cvt.v;
            } else {
                bf = *(const bf16x8*)(MKB + ((size_t)(b * 256 + mrow)) * 1024 + h * 256 + 32 * ks + 8 * kg);
            }
#pragma unroll
            for (int mt = 0; mt < MT; ++mt) acc[mt][nt] = __builtin_amdgcn_mfma_f32_16x16x32_bf16(qa[mt][ks], bf, acc[mt][nt], 0, 0, 0);
        }
    }
#pragma unroll
    for (int mt = 0; mt < MT; ++mt)
#pragma unroll
        for (int nt = 0; nt < 2; ++nt)
#pragma unroll
            for (int i = 0; i < 4; ++i) Sb[(16 * mt + 4 * kg + i) * 260 + 32 * wv + 16 * nt + fr] = acc[mt][nt][i] * 0.0625f;
    __syncthreads();
    for (int rr = wv; rr < 16 * MT; rr += 8) {
        const float4 s = *(const float4*)(Sb + rr * 260 + lane * 4);
        const float mx = wmaxf(fmaxf(fmaxf(s.x, s.y), fmaxf(s.z, s.w)));
        const float e0 = __expf(s.x - mx), e1 = __expf(s.y - mx), e2 = __expf(s.z - mx), e3 = __expf(s.w - mx);
        const float inv = 1.f / wsum(e0 + e1 + e2 + e3);
        uint2 pk; pk.x = cvt_pk_bf16(e0 * inv, e1 * inv); pk.y = cvt_pk_bf16(e2 * inv, e3 * inv);
        *(uint2*)(Pb + rr * 264 + lane * 4) = pk;
    }
    __syncthreads();
#pragma unroll
    for (int mt = 0; mt < MT; ++mt) { acc[mt][0] = (f32x4){0.f, 0.f, 0.f, 0.f}; acc[mt][1] = acc[mt][0]; }
    if (SAMPLE) {
        const float* vbase = p.cv + ((size_t)(b * 256 + 8 * kg)) * 1024 + h * 256 + 32 * wv + fr;
#pragma unroll 1
        for (int ks = 0; ks < 8; ++ks) {
            const float* vp = vbase + (size_t)ks * 32 * 1024;
            float x0[8], x1[8];
#pragma unroll
            for (int j = 0; j < 8; ++j) { x0[j] = vp[(size_t)j * 1024]; x1[j] = vp[(size_t)j * 1024 + 16]; }
            union { bf16x8 v; unsigned u[4]; } c0, c1;
#pragma unroll
            for (int j = 0; j < 4; ++j) { c0.u[j] = cvt_pk_bf16(x0[2 * j], x0[2 * j + 1]); c1.u[j] = cvt_pk_bf16(x1[2 * j], x1[2 * j + 1]); }
            const bf16x8 pa = *(const bf16x8*)(Pb + fr * 264 + 32 * ks + 8 * kg);
            acc[0][0] = __builtin_amdgcn_mfma_f32_16x16x32_bf16(pa, c0.v, acc[0][0], 0, 0, 0);
            acc[0][1] = __builtin_amdgcn_mfma_f32_16x16x32_bf16(pa, c1.v, acc[0][1], 0, 0, 0);
        }
    } else {
#pragma unroll
        for (int nt = 0; nt < 2; ++nt) {
            const int dcol = 32 * wv + 16 * nt + fr;
#pragma unroll
            for (int ks = 0; ks < 8; ++ks) {
                const bf16x8 bf = *(const bf16x8*)(MVT + ((size_t)((b * 4 + h) * 256 + dcol)) * 256 + 32 * ks + 8 * kg);
#pragma unroll
                for (int mt = 0; mt < MT; ++mt) {
                    const bf16x8 pa = *(const bf16x8*)(Pb + (16 * mt + fr) * 264 + 32 * ks + 8 * kg);
                    acc[mt][nt] = __builtin_amdgcn_mfma_f32_16x16x32_bf16(pa, bf, acc[mt][nt], 0, 0, 0);
                }
            }
        }
    }
#pragma unroll
    for (int mt = 0; mt < MT; ++mt)
#pragma unroll
        for (int nt = 0; nt < 2; ++nt)
#pragma unroll
            for (int i = 0; i < 4; ++i) {
                const int rl = 16 * mt + 4 * kg + i;
                if (!SAMPLE || rl < 8) COUT[(size_t)(r0 + rl) * 1024 + h * 256 + 32 * wv + 16 * nt + fr] = f2bf(acc[mt][nt][i]);
            }
    __syncthreads();
}

__device__ void sgu_prompt_item(const P& p, unsigned char* smem, int b, int ch, int g) {
    bf16_t* VT = (bf16_t*)smem;
    const float* GV = (const float*)(p.ws + OFF_GV);
    const float* LNST = (const float*)(p.ws + OFF_LNST);
    const bf16_t* WSB = (const bf16_t*)(p.ws + OFF_WSB);
    const bf16_t* U = (const bf16_t*)(p.ws + OFF_U);
    bf16_t* BOUT = (bf16_t*)(p.ws + OFF_BR) + (size_t)NTOK * 1024;
    const int tid = threadIdx.x, lane = tid & 63, wv = tid >> 6, fr = lane & 15, kg = lane >> 4;
    const int row0 = b * 2048 + ch * 128;
    {
        const int s = tid >> 2, c0 = (tid & 3) * 32;
        const float mean = LNST[(size_t)(row0 + s) * 2], rstd = LNST[(size_t)(row0 + s) * 2 + 1];
#pragma unroll
        for (int q = 0; q < 8; ++q) {
            const float4 x = *(const float4*)(GV + (size_t)(row0 + s) * 1024 + g * 128 + c0 + 4 * q);
            const float4 gm = *(const float4*)(p.sgu_g + g * 128 + c0 + 4 * q), bt = *(const float4*)(p.sgu_b + g * 128 + c0 + 4 * q);
            VT[(c0 + 4 * q + 0) * 136 + s] = f2bf((x.x - mean) * rstd * gm.x + bt.x);
            VT[(c0 + 4 * q + 1) * 136 + s] = f2bf((x.y - mean) * rstd * gm.y + bt.y);
            VT[(c0 + 4 * q + 2) * 136 + s] = f2bf((x.z - mean) * rstd * gm.z + bt.z);
            VT[(c0 + 4 * q + 3) * 136 + s] = f2bf((x.w - mean) * rstd * gm.w + bt.w);
        }
    }
    __syncthreads();
    const int t0 = 16 * wv;
    f32x4 acc[8];
#pragma unroll
    for (int nt = 0; nt < 8; ++nt) acc[nt] = (f32x4){0.f, 0.f, 0.f, 0.f};
#pragma unroll
    for (int ks = 0; ks < 4; ++ks) {
        if (32 * ks <= t0 + 15) {
            const bf16x8 af = *(const bf16x8*)(WSB + (size_t)(g * 128 + t0 + fr) * 128 + 32 * ks + 8 * kg);
#pragma unroll
            for (int nt = 0; nt < 8; ++nt) {
                const bf16x8 bf = *(const bf16x8*)(VT + (16 * nt + fr) * 136 + 32 * ks + 8 * kg);
                acc[nt] = __builtin_amdgcn_mfma_f32_16x16x32_bf16(af, bf, acc[nt], 0, 0, 0);
            }
        }
    }
#pragma unroll
    for (int i = 0; i < 4; ++i) {
        const int t = t0 + 4 * kg + i;
        const float bs = p.b_s[g * 128 + t];
#pragma unroll
        for (int nt = 0; nt < 8; ++nt) {
            const size_t idx = (size_t)(row0 + t) * 1024 + g * 128 + 16 * nt + fr;
            BOUT[idx] = f2bf(bf2f(U[idx]) * (acc[nt][i] + bs));
        }
    }
    __syncthreads();
}
__device__ void sgu_sample_item(const P& p, int b) {
    const float* GV = (const float*)(p.ws + OFF_GV);
    const float* LNST = (const float*)(p.ws + OFF_LNST);
    const bf16_t* U = (const bf16_t*)(p.ws + OFF_U);
    bf16_t* BOUT = (bf16_t*)(p.ws + OFF_BR) + (size_t)NTOK * 1024;
    const int c0 = 2 * threadIdx.x, g = c0 >> 7, row0 = NP + b * 8;
    const float2 gm = *(const float2*)(p.sgu_g + c0), bt = *(const float2*)(p.sgu_b + c0);
    float2 v[8];
#pragma unroll
    for (int s = 0; s < 8; ++s) {
        const float mean = LNST[(size_t)(row0 + s) * 2], rstd = LNST[(size_t)(row0 + s) * 2 + 1];
        const float2 x = *(const float2*)(GV + (size_t)(row0 + s) * 1024 + c0);
        v[s].x = (x.x - mean) * rstd * gm.x + bt.x; v[s].y = (x.y - mean) * rstd * gm.y + bt.y;
        *(float2*)(p.out + O_SGUV + (size_t)(b * 8 + s) * 1024 + c0) = v[s];
    }
#pragma unroll
    for (int t = 0; t < 8; ++t) {
        float sx = p.b_s[g * 128 + t], sy = sx;
#pragma unroll
        for (int s = 0; s <= t; ++s) { const float w = p.w_s[(size_t)(g * 128 + t) * 128 + s]; sx += w * v[s].x; sy += w * v[s].y; }
        const size_t idx = (size_t)(row0 + t) * 1024 + c0;
        const unsigned uu = *(const unsigned*)(U + idx);
        *(unsigned*)(BOUT + idx) = cvt_pk_bf16(bflo(uu) * sx, bfhi(uu) * sy);
    }
}
__device__ void phase_mix(const P& p, unsigned char* smem) {
    const int bid = blockIdx.x, G = gridDim.x;
    const int NSC = 64;
    if (bid < NSC) {
        for (int rr_ = 0; rr_ < 1 + (int)((p.rep_mask >> 16) & 1); ++rr_)
        for (int s = bid; s < 64; s += NSC) { const int b = s >> 4, h = s & 15; scan_seq(p, smem, b * 2048, 2048, h, nullptr, p.out + O_WKVP + (size_t)s * 4096); }
        return;
    }
    const int j = bid - NSC, nb = G - NSC;
    for (int rr_ = 0; rr_ < 1 + (int)((p.rep_mask >> 17) & 1); ++rr_) {
#ifndef MIXSEL
#define MIXSEL 31
#endif
    for (int r2_ = 0; r2_ < 1 + (int)((p.rep_mask >> 18) & 1); ++r2_)
    if (MIXSEL & 1) for (int it = j; it < 512; it += nb) attn_item<true>(p, smem, it >> 2, it & 3, NP + (it >> 2) * 8);
    for (int r2_ = 0; r2_ < 1 + (int)((p.rep_mask >> 19) & 1); ++r2_)
    if (MIXSEL & 2) for (int it = j; it < 1024; it += nb) { const int b = it >> 8, h = (it >> 6) & 3, qt = it & 63; attn_item<false>(p, smem, b, h, b * 2048 + qt * 32); }
    for (int r2_ = 0; r2_ < 1 + (int)((p.rep_mask >> 20) & 1); ++r2_)
    if (MIXSEL & 4) for (int it = j; it < 512; it += nb) sgu_prompt_item(p, smem, it >> 7, (it >> 3) & 15, it & 7);
    if (MIXSEL & 8) for (int it = j; it < 128; it += nb) sgu_sample_item(p, it);
    for (int r2_ = 0; r2_ < 1 + (int)((p.rep_mask >> 21) & 1); ++r2_)
    if (MIXSEL & 16) for (int it = j; it < 2048; it += nb) { const int b = it >> 4, h = it & 15; scan_seq(p, smem, NP + b * 8, 8, h, p.st_wkv + (size_t)it * 4096, p.out + O_WKVS + (size_t)it * 4096); }
    }
    convert_tiles(p, smem, 7296, 18304, j, nb);
}

__device__ void phase_postmix(const P& p, unsigned char* smem) {
    int* tm = (int*)smem; build_tailmap(tm);
    const float* PART = (const float*)(p.ws + OFF_PART);
    const bf16_t* MIX = (const bf16_t*)(p.ws + OFF_MIX);
    float* H = (float*)(p.ws + OFF_H);
    bf16_t* HN = (bf16_t*)(p.ws + OFF_HN);
    const int lane = threadIdx.x & 63, wv = threadIdx.x >> 6;
    for (int r = blockIdx.x * 8 + wv; r < NTOK; r += gridDim.x * 8) {
        const float* x = r < NP ? p.x_p + (size_t)r * 2048 : p.x_s + (size_t)(r - NP) * 2048;
        const bf16_t* mr = MIX + (size_t)r * 2048;
        float4 v[8]; float ss = 0.f;
#pragma unroll
        for (int i = 0; i < 8; ++i) { const int tt = tm[(r >> 8) * 8 + i]; v[i] = tt < 0 ? ld4bf(mr + (i * 64 + lane) * 4) : sum_parts(PART, tt, r & 255, lane); ss += v[i].x * v[i].x + v[i].y * v[i].y + v[i].z * v[i].z + v[i].w * v[i].w; }
        const float r1 = rsqrtf(wsum(ss) * (1.f / 2048.f) + 1e-6f);
        float s2 = 0.f;
#pragma unroll
        for (int i = 0; i < 8; ++i) {
            const float4 xx = *(const float4*)(x + (i * 64 + lane) * 4), gg = *(const float4*)(p.g_post_mix + (i * 64 + lane) * 4);
            v[i].x = xx.x + v[i].x * r1 * gg.x; v[i].y = xx.y + v[i].y * r1 * gg.y; v[i].z = xx.z + v[i].z * r1 * gg.z; v[i].w = xx.w + v[i].w * r1 * gg.w;
            s2 += v[i].x * v[i].x + v[i].y * v[i].y + v[i].z * v[i].z + v[i].w * v[i].w;
            *(float4*)(H + (size_t)r * 2048 + (i * 64 + lane) * 4) = v[i];
        }
        const float r2 = rsqrtf(wsum(s2) * (1.f / 2048.f) + 1e-6f);
#pragma unroll
        for (int i = 0; i < 8; ++i) {
            const float4 gg = *(const float4*)(p.g_pre_ffn + (i * 64 + lane) * 4);
            uint2 pk; pk.x = cvt_pk_bf16(v[i].x * r2 * gg.x, v[i].y * r2 * gg.y); pk.y = cvt_pk_bf16(v[i].z * r2 * gg.z, v[i].w * r2 * gg.w);
            *(uint2*)(HN + (size_t)r * 2048 + (i * 64 + lane) * 4) = pk;
        }
    }
}
__device__ void phase_final(const P& p, unsigned char* smem) {
    int* tm = (int*)smem; build_tailmap(tm);
    const float* PART = (const float*)(p.ws + OFF_PART);
    const bf16_t* F = (const bf16_t*)(p.ws + OFF_F);
    const float* H = (const float*)(p.ws + OFF_H);
    const int lane = threadIdx.x & 63, wv = threadIdx.x >> 6;
    for (int r = blockIdx.x * 8 + wv; r < NTOK; r += gridDim.x * 8) {
        const bf16_t* fr = F + (size_t)r * 2048;
        float4 v[8]; float ss = 0.f;
#pragma unroll
        for (int i = 0; i < 8; ++i) { const int tt = tm[(r >> 8) * 8 + i]; v[i] = tt < 0 ? ld4bf(fr + (i * 64 + lane) * 4) : sum_parts(PART, tt, r & 255, lane); ss += v[i].x * v[i].x + v[i].y * v[i].y + v[i].z * v[i].z + v[i].w * v[i].w; }
        const float r1 = rsqrtf(wsum(ss) * (1.f / 2048.f) + 1e-6f);
#pragma unroll
        for (int i = 0; i < 8; ++i) {
            const float4 hh = *(const float4*)(H + (size_t)r * 2048 + (i * 64 + lane) * 4), gg = *(const float4*)(p.g_post_ffn + (i * 64 + lane) * 4);
            float4 o; o.x = hh.x + v[i].x * r1 * gg.x; o.y = hh.y + v[i].y * r1 * gg.y; o.z = hh.z + v[i].z * r1 * gg.z; o.w = hh.w + v[i].w * r1 * gg.w;
            *(float4*)(p.out + O_Y + (size_t)r * 2048 + (i * 64 + lane) * 4) = o;
        }
    }
}
__device__ __forceinline__ void ld8bf(const bf16_t* ptr, float (&o)[8]) {
    const uint4 u = *(const uint4*)ptr;
    o[0] = bflo(u.x); o[1] = bfhi(u.x); o[2] = bflo(u.y); o[3] = bfhi(u.y); o[4] = bflo(u.z); o[5] = bfhi(u.z); o[6] = bflo(u.w); o[7] = bfhi(u.w);
}
__device__ __forceinline__ void ld8f(const float* ptr, float (&o)[8]) {
    const float4 a = *(const float4*)ptr, b = *(const float4*)(ptr + 4);
    o[0] = a.x; o[1] = a.y; o[2] = a.z; o[3] = a.w; o[4] = b.x; o[5] = b.y; o[6] = b.z; o[7] = b.w;
}
__device__ void phase_conv(const P& p) {
    const bf16_t* UP = (const bf16_t*)(p.ws + OFF_UP);
    bf16_t* ACT = (bf16_t*)(p.ws + OFF_ACT);
    const int ntask = (NTOK / 8) * 704;
    for (int task = blockIdx.x * 512 + threadIdx.x; task < ntask; task += gridDim.x * 512) {
        const int rt = task / 704, cgp = task - rt * 704, row0 = rt * 8, cg0 = cgp * 8, cv0 = DFF + cgp * 8;
        float w0g[8], w1g[8], w2g[8], bg[8], w0v[8], w1v[8], w2v[8], bv[8];
        ld8f(p.conv_w + cg0, w0g); ld8f(p.conv_w + F2 + cg0, w1g); ld8f(p.conv_w + 2 * F2 + cg0, w2g); ld8f(p.conv_b + cg0, bg);
        ld8f(p.conv_w + cv0, w0v); ld8f(p.conv_w + F2 + cv0, w1v); ld8f(p.conv_w + 2 * F2 + cv0, w2v); ld8f(p.conv_b + cv0, bv);
        float e0g[8], e1g[8], e0v[8], e1v[8];
        if (row0 >= NP) {
            const float* st = p.st_conv + (size_t)(rt - NP / 8) * 2 * F2;
            ld8f(st + cg0, e0g); ld8f(st + F2 + cg0, e1g); ld8f(st + cv0, e0v); ld8f(st + F2 + cv0, e1v);
        } else if ((row0 & 2047) == 0) {
#pragma unroll
            for (int j = 0; j < 8; ++j) { e0g[j] = 0.f; e1g[j] = 0.f; e0v[j] = 0.f; e1v[j] = 0.f; }
        } else {
            ld8bf(UP + (size_t)(row0 - 2) * F2 + cg0, e0g); ld8bf(UP + (size_t)(row0 - 1) * F2 + cg0, e1g);
            ld8bf(UP + (size_t)(row0 - 2) * F2 + cv0, e0v); ld8bf(UP + (size_t)(row0 - 1) * F2 + cv0, e1v);
        }
        uint4 ugA[8], uvA[8];
#pragma unroll
        for (int t = 0; t < 8; ++t) { ugA[t] = *(const uint4*)(UP + (size_t)(row0 + t) * F2 + cg0); uvA[t] = *(const uint4*)(UP + (size_t)(row0 + t) * F2 + cv0); }
#pragma unroll
        for (int t = 0; t < 8; ++t) {
            float cgv[8], cvv[8];
            { const uint4 u = ugA[t]; cgv[0] = bflo(u.x); cgv[1] = bfhi(u.x); cgv[2] = bflo(u.y); cgv[3] = bfhi(u.y); cgv[4] = bflo(u.z); cgv[5] = bfhi(u.z); cgv[6] = bflo(u.w); cgv[7] = bfhi(u.w); }
            { const uint4 u = uvA[t]; cvv[0] = bflo(u.x); cvv[1] = bfhi(u.x); cvv[2] = bflo(u.y); cvv[3] = bfhi(u.y); cvv[4] = bflo(u.z); cvv[5] = bfhi(u.z); cvv[6] = bflo(u.w); cvv[7] = bfhi(u.w); }
            float o[8];
#pragma unroll
            for (int j = 0; j < 8; ++j) {
                const float gt = bg[j] + w0g[j] * e0g[j] + w1g[j] * e1g[j] + w2g[j] * cgv[j];
                const float vl = bv[j] + w0v[j] * e0v[j] + w1v[j] * e1v[j] + w2v[j] * cvv[j];
                o[j] = gelu_t(gt) * vl;
                e0g[j] = e1g[j]; e1g[j] = cgv[j]; e0v[j] = e1v[j]; e1v[j] = cvv[j];
            }
            uint4 pk; pk.x = cvt_pk_bf16(o[0], o[1]); pk.y = cvt_pk_bf16(o[2], o[3]); pk.z = cvt_pk_bf16(o[4], o[5]); pk.w = cvt_pk_bf16(o[6], o[7]);
            *(uint4*)(ACT + (size_t)(row0 + t) * DFF + cg0) = pk;
        }
    }
}

__device__ __forceinline__ unsigned xb_ld(unsigned* p) { return __hip_atomic_load(p, __ATOMIC_RELAXED, __HIP_MEMORY_SCOPE_AGENT); }
__device__ __forceinline__ unsigned xb_add(unsigned* p, unsigned v) { return __hip_atomic_fetch_add(p, v, __ATOMIC_RELAXED, __HIP_MEMORY_SCOPE_AGENT); }
__device__ __forceinline__ unsigned xb_xcc_id() { return (unsigned)__builtin_amdgcn_s_getreg((3 << 11) | 20) & 0xFu; }
#define XB_SPIN(cond) do { unsigned sp_ = 0; while (cond) { __builtin_amdgcn_s_sleep(1); if (++sp_ > (1u << 17)) break; } } while (0)
__device__ __forceinline__ void fast_grid_barrier(unsigned* bar, volatile unsigned* st) {
    asm volatile("s_waitcnt vmcnt(0)" ::: "memory");
    __syncthreads();
    if (threadIdx.x == 0) {
        const unsigned x = xb_xcc_id();
        const unsigned nloc = st[0], nx = st[1];
        const unsigned old = xb_add(&bar[64 * (16 + x)], 1u);
        const unsigned gen = old / nloc;
        if (old + 1u == (gen + 1u) * nloc) {
            __builtin_amdgcn_fence(__ATOMIC_RELEASE, "agent");
            asm volatile("s_waitcnt vmcnt(0)" ::: "memory");
            const unsigned og = xb_add(&bar[64 * 48], 1u);
            const unsigned tg = og / nx;
            if (og + 1u == (tg + 1u) * nx) (void)xb_add(&bar[64 * 49], 1u);
            else XB_SPIN(xb_ld(&bar[64 * 49]) == tg);
            __builtin_amdgcn_fence(__ATOMIC_ACQUIRE, "agent");
            (void)xb_add(&bar[64 * (32 + x)], 1u);
            asm volatile("s_waitcnt vmcnt(0)" ::: "memory");
        } else {
            XB_SPIN(xb_ld(&bar[64 * (32 + x)]) == gen);
            __builtin_amdgcn_fence(__ATOMIC_ACQUIRE, "agent");
            asm volatile("s_waitcnt vmcnt(0)" ::: "memory");
        }
    }
    __syncthreads();
}
__global__ void __launch_bounds__(512) fwd_kernel(P p) {
    extern __shared__ __attribute__((aligned(16))) unsigned char smem[];
    cg::grid_group grid = cg::this_grid();
    unsigned char* ws = p.ws;
    const int G = gridDim.x;
    const int lo = (int)p.ph_lo, hi = (int)p.ph_hi;
    unsigned* gbar = (unsigned*)(ws + OFF_BAR);
    __shared__ unsigned xb_state[4];
    if (threadIdx.x == 0) {
        const unsigned x = xb_xcc_id(); const unsigned rank = xb_add(&gbar[64 * x], 1u);
        unsigned nloc = 1u, nx = 1u, sp = 0, reg_ = 0u;
        for (;;) {
            unsigned sum = 0u, cnt = 0u, mine = 0u; reg_ = 1u;
            for (unsigned j = 0; j < 16; ++j) { const unsigned cj = xb_ld(&gbar[64 * j]); sum += cj; cnt += (cj > 0u) ? 1u : 0u; mine = (j == x) ? cj : mine; if (cj != 0u && (cj * 8u != (unsigned)gridDim.x || j >= 8u)) reg_ = 0u; }
            nloc = mine > 0u ? mine : 1u; nx = cnt > 0u ? cnt : 1u;
            if (sum == (unsigned)gridDim.x) break;
            __builtin_amdgcn_s_sleep(1); if (++sp > (1u << 17)) { reg_ = 0u; break; }
        }
        xb_state[0] = nloc; xb_state[1] = nx;
        xb_state[2] = (reg_ && nx == 8u && rank < nloc) ? x + 8u * rank : (unsigned)blockIdx.x;
        xb_state[3] = reg_;
    }
    __syncthreads();
    const int c = (int)xb_state[2];
    if (p.rep_mask == 0x7fffffffffffffffll) grid.sync();
#ifndef PH_MASK
#define PH_MASK 0x7ff
#endif
#define PHON(k) ((PH_MASK >> (k)) & 1)
#define PHRUN(k) (PHON(k) && lo <= (k) && (k) < hi)
#define PHSYNC(k) if (lo < (k) && (k) < hi) fast_grid_barrier(gbar, xb_state);
#ifdef TIMING_REPS
#define RUN_PHASE(k, ...) PHSYNC(k) if (PHRUN(k)) { const int nrep_ = 1 + (int)((p.rep_mask >> (k)) & 1); for (int rep_ = 0; rep_ < nrep_; ++rep_) { if (rep_) grid.sync(); __VA_ARGS__ } }
#else
#define RUN_PHASE(k, ...) PHSYNC(k) if (PHRUN(k)) { __VA_ARGS__ }
#endif
    RUN_PHASE(0, phase0(p, smem);)
    RUN_PHASE(1,
        pg8::Gemm g{(const bf16_t*)(ws + OFF_XN), (const bf16_t*)(ws + OFF_WIN), NTOK, 12544, 2048};
        pg8::StaticOrder S; S.init(NTOK, 12544, 2048, G, c);
        EpiProj E{(float*)(ws + OFF_RW), (bf16_t*)(ws + OFF_U), (float*)(ws + OFF_GV), (bf16_t*)(ws + OFF_Q), (bf16_t*)(ws + OFF_GT), p.out};
        pg8::gemm_phase((LAS unsigned char*)smem, g, S, E);
        )
    RUN_PHASE(2, phase_prep(p, smem);
        pg8::Gemm g2{(const bf16_t*)(ws + OFF_MN), (const bf16_t*)(ws + OFF_WMEM), 1024, 2048, 2048};
        pg8::StaticOrder S2; S2.init(1024, 2048, 2048, G, G - 1 - (int)blockIdx.x);
        EpiMem E2{p.out, (bf16_t*)(ws + OFF_MKB), (bf16_t*)(ws + OFF_MVT)};
        pg8::gemm_phase((LAS unsigned char*)smem, g2, S2, E2);)
    RUN_PHASE(3, phase_mix(p, smem);)
    RUN_PHASE(4,
        pg8::Gemm g{(const bf16_t*)(ws + OFF_BR), (const bf16_t*)(ws + OFF_WBR), NTOK, 2048, 1024};
        pg8::BranchOrder S{G, c};
        EpiBranch E{(const bf16_t*)(ws + OFF_GT), (bf16_t*)(ws + OFF_MIXSUM), (float*)(ws + OFF_PART)};
        pg8::gemm_phase((LAS unsigned char*)smem, g, S, E);)
    if (lo <= 4 && 5 < hi) { fast_grid_barrier(gbar, xb_state); reduce_branch_tail((const float*)(ws + OFF_PART), (bf16_t*)(ws + OFF_MIXSUM)); }
    RUN_PHASE(5,
        pg8::Gemm g{(const bf16_t*)(ws + OFF_MIXSUM), (const bf16_t*)(ws + OFF_WOUT), NTOK, 2048, 2048};
        pg8::TailSplitOrder S{c, 32};
        EpiF32 E{(bf16_t*)(ws + OFF_MIX), 2048, (float*)(ws + OFF_PART)};
        pg8::gemm_phase((LAS unsigned char*)smem, g, S, E);)
    RUN_PHASE(6, phase_postmix(p, smem);)
    RUN_PHASE(7,
        pg8::Gemm g{(const bf16_t*)(ws + OFF_HN), (const bf16_t*)(ws + OFF_WUP), NTOK, F2, 2048};
        pg8::StaticOrder S; S.init(NTOK, F2, 2048, G, c);
        EpiUp E{(bf16_t*)(ws + OFF_UP), p.out};
        pg8::gemm_phase((LAS unsigned char*)smem, g, S, E);)
    RUN_PHASE(8, phase_conv(p);)
    RUN_PHASE(9,
        pg8::Gemm g{(const bf16_t*)(ws + OFF_ACT), (const bf16_t*)(ws + OFF_WDOWN), NTOK, 2048, DFF};
        pg8::TailSplitOrder S{c, 88};
        EpiF32 E{(bf16_t*)(ws + OFF_F), 2048, (float*)(ws + OFF_PART)};
        pg8::gemm_phase((LAS unsigned char*)smem, g, S, E);)
    RUN_PHASE(10, phase_final(p, smem);)
}

#ifndef MK_MULTI
#define MK_MULTI 0
#endif
extern "C" void kernel_launch(void* const* d_in, const int* in_sizes, int n_in, void* d_out, int out_size, void* d_ws, size_t ws_size, hipStream_t stream) {
    static int grid = 0;
    if (grid == 0) {
        if (n_in != 37 || ws_size < WS_END) { fprintf(stderr, "kernel_launch: bad n_in %d or ws_size %zu < %zu\n", n_in, ws_size, (size_t)WS_END); grid = -1; return; }
        int dev = 0, cus = 0, per_cu = 0;
        hipGetDevice(&dev);
        hipDeviceGetAttribute(&cus, hipDeviceAttributeMultiprocessorCount, dev);
        if (hipFuncSetAttribute((const void*)fwd_kernel, hipFuncAttributeMaxDynamicSharedMemorySize, LDS_BYTES) != hipSuccess) { fprintf(stderr, "hipFuncSetAttribute failed\n"); grid = -1; return; }
        if (hipOccupancyMaxActiveBlocksPerMultiprocessor(&per_cu, (const void*)fwd_kernel, 512, LDS_BYTES) != hipSuccess || per_cu < 1) { fprintf(stderr, "occupancy query failed (%d)\n", per_cu); grid = -1; return; }
        grid = cus * per_cu;
        if (grid > 256) grid = 256;
    }
    if (grid != 256) return;
    P p{};
    const float** pp = (const float**)&p;
    for (int i = 0; i < 37; ++i) pp[i] = (const float*)d_in[i];
    p.out = (float*)d_out; p.ws = (unsigned char*)d_ws;
#if MK_MULTI
    for (int ph = 0; ph < NPHASE; ++ph) {
        p.ph_lo = ph; p.ph_hi = ph + 1;
        hipLaunchKernelGGL(fwd_kernel, dim3(grid), dim3(512), LDS_BYTES, stream, p);
    }
#else
    p.ph_lo = 0; p.ph_hi = NPHASE;
    if (hipMemsetAsync((unsigned char*)d_ws + OFF_BAR, 0, 50 * 256, stream) != hipSuccess) { fprintf(stderr, "memset of barrier words failed\n"); return; }
#ifdef TIMING_REPS
    p.rep_mask = TIMING_REPS;
#endif
    void* args[] = {&p};
    hipError_t e = hipLaunchCooperativeKernel((const void*)fwd_kernel, dim3(grid), dim3(512), args, LDS_BYTES, stream);
    if (e != hipSuccess) fprintf(stderr, "cooperative launch failed: %s (grid %d)\n", hipGetErrorString(e), grid);
#endif
}
```

```cpp
#include <hip/hip_runtime.h>
#include <hip/hip_cooperative_groups.h>
#include <cstdio>
namespace cg = cooperative_groups;

#define LAS __attribute__((address_space(3)))
typedef unsigned short bf16_t;
typedef short bf16x8 __attribute__((ext_vector_type(8)));
typedef float f32x4 __attribute__((ext_vector_type(4)));
typedef float f32x2 __attribute__((ext_vector_type(2)));

constexpr int NP = 8192, NTOK = 9216, NSH = 3328, F2 = 11264, DFF = 5632;
constexpr int LDS_BYTES = 131072;
constexpr int NPHASE = 11;

constexpr size_t O_Y = 0, O_WKVP = 18874368, O_SHP = 19136512, O_MK = 19149824, O_MV = 20198400, O_CVP = 21246976,
                 O_WKVS = 21337088, O_SHS = 29725696, O_SGUV = 30151680, O_CVS = 31200256;
constexpr size_t OFF_WBR = 0, OFF_WOUT = OFF_WBR + 12582912, OFF_WUP = OFF_WOUT + 8388608, OFF_WDOWN = OFF_WUP + 46137344,
                 OFF_WSB = OFF_WDOWN + 23068672, OFF_MKB = OFF_WSB + 262144, OFF_MVT = OFF_MKB + 2097152, OFF_LNST = OFF_MVT + 2097152,
                 OFF_BAR = OFF_LNST + 98304,     OFF_WLR = OFF_LNST + 131072, OFF_R2 = OFF_WLR + 524288, SZ_R2 = 264241152, OFF_R1 = OFF_R2 + SZ_R2, SZ_R1 = 122683392, OFF_R3 = OFF_R1 + SZ_R1,
                 SZ_R3 = 188743680, OFF_WMEM = OFF_R3 + SZ_R3, OFF_MN = OFF_WMEM + 8388608, WS_END = OFF_MN + 4194304;
constexpr size_t OFF_WIN = OFF_R2, OFF_XN = OFF_WIN + 51380224;
constexpr size_t OFF_PREP = OFF_R2;
constexpr size_t OFF_ACC32 = OFF_R2, OFF_MIXSUM = OFF_R2 + 75497472, OFF_MIX = OFF_R2 + 113246208;
constexpr size_t OFF_PART = OFF_R2, OFF_UP = OFF_R2, OFF_F = OFF_R3 + 104857600;
constexpr size_t OFF_RW = OFF_R1, OFF_BR = OFF_R1, OFF_H = OFF_R1, OFF_HN = OFF_R1 + 75497472;
constexpr size_t OFF_U = OFF_R3, OFF_GV = OFF_U + 18874368, OFF_Q = OFF_GV + 37748736, OFF_GT = OFF_Q + 18874368, OFF_ACT = OFF_R3;

struct P {
    const float *x_p, *x_s, *mem_p, *st_wkv, *st_shift, *ck, *cv, *st_conv;
    const float *g_pre_mix, *w_in, *mu, *w0, *w_decay, *a0, *w_aaa, *w_gate, *k_k, *k_a, *r_k, *lnx_w, *lnx_b, *sgu_g, *sgu_b, *w_s, *b_s,
        *g_mem, *w_mem_k, *w_mem_v, *w_branch, *w_out, *g_post_mix, *g_pre_ffn, *w_up, *conv_w, *conv_b, *w_down, *g_post_ffn;
    float* out;
    unsigned char* ws;
    long long ph_lo, ph_hi, rep_mask, pad_;
};

typedef __bf16 bf16x2v __attribute__((ext_vector_type(2)));
__device__ __forceinline__ unsigned cvt_pk_bf16(float lo, float hi) { const f32x2 v = {lo, hi}; const bf16x2v b = __builtin_convertvector(v, bf16x2v); return __builtin_bit_cast(unsigned, b); }
__device__ __forceinline__ bf16_t f2bf(float f) { return (bf16_t)(cvt_pk_bf16(f, 0.f) & 0xffffu); }
__device__ __forceinline__ float bf2f(bf16_t b) { return __uint_as_float(((unsigned)b) << 16); }
__device__ __forceinline__ float bflo(unsigned u) { return __uint_as_float(u << 16); }
__device__ __forceinline__ float bfhi(unsigned u) { return __uint_as_float(u & 0xffff0000u); }
__device__ __forceinline__ float wsum(float v) {
#pragma unroll
    for (int o = 32; o; o >>= 1) v += __shfl_xor(v, o);
    return v;
}
__device__ __forceinline__ float wmaxf(float v) {
#pragma unroll
    for (int o = 32; o; o >>= 1) v = fmaxf(v, __shfl_xor(v, o));
    return v;
}
__device__ __forceinline__ float hsum32(float v) {
#pragma unroll
    for (int o = 16; o; o >>= 1) v += __shfl_xor(v, o);
    return v;
}
__device__ __forceinline__ float gelu_t(float x) {
    const float z = 0.7978845608f * (x + 0.044715f * x * x * x);
    const float e = __expf(2.f * z);
    const float t = 1.f - 2.f / (e + 1.f);
    return 0.5f * x * (1.f + t);
}
__device__ __forceinline__ float sigm(float x) { return 1.f / (1.f + __expf(-x)); }
__device__ __forceinline__ float dpp_x1(float v) { return __int_as_float(__builtin_amdgcn_mov_dpp(__float_as_int(v), 0xB1, 0xF, 0xF, true)); }
__device__ __forceinline__ float dpp_x2(float v) { return __int_as_float(__builtin_amdgcn_mov_dpp(__float_as_int(v), 0x4E, 0xF, 0xF, true)); }
__device__ __forceinline__ float dpp_hm(float v) { return __int_as_float(__builtin_amdgcn_mov_dpp(__float_as_int(v), 0x141, 0xF, 0xF, true)); }
__device__ __forceinline__ float red8(float v) { v += dpp_x1(v); v += dpp_x2(v); v += dpp_hm(v); return v; }

namespace pg8 {
constexpr int BM = 256, BK = 64, HALF = 128, HTB = HALF * BK * 2, NXCD = 8, WGM = 8;
__device__ __forceinline__ int lds_byte(int r, int c) { const int st = (r >> 4) * 2 + (c >> 5), rr = r & 15, cc = c & 31, ob = rr * 64 + cc * 2; return st * 1024 + (ob ^ (((ob >> 9) & 1) << 5)); }
__device__ __forceinline__ void stage_rc(int b, int& R, int& C) { const int st = b / 1024, sb = b % 1024, swz = sb ^ (((sb >> 9) & 1) << 5); R = (st >> 1) * 16 + swz / 64; C = (st & 1) * 32 + (swz % 64) / 2; }
__device__ __forceinline__ int perm32(int rho) { const int n = rho >> 4, i = rho & 15; return 8 * (i >> 2) + 4 * n + (i & 3); }
struct Unit { int pm, pn, k0, nt, part; };
struct Gemm { const bf16_t* A; const bf16_t* Bt; int M, N, K; };
__device__ __forceinline__ void tile_remap(int L, int nM, int nN, int& pm, int& pn) {
    const int nwg = nM * nN; int wgid = L;
    { const int q = nwg / NXCD, r = nwg % NXCD, xcd = wgid % NXCD, off = wgid / NXCD; wgid = (xcd < r ? xcd * (q + 1) : r * (q + 1) + (xcd - r) * q) + off; }
    const int nig = WGM * nN, gid = wgid / nig, fm = gid * WGM, gsz = (nM - fm) < WGM ? (nM - fm) : WGM;
    pm = fm + ((wgid % nig) % gsz); pn = (wgid % nig) / gsz;
}
struct StaticOrder {
    int nM, nN, nwg, G, c, ntk;
    __device__ void init(int M, int N, int K, int G_, int c_) { nM = M / BM; nN = N / BM; nwg = nM * nN; G = G_; c = c_; ntk = K / BK; }
    __device__ bool next(int i, Unit& u) const {
        const long L = (long)i * G + c; if (L >= nwg) return false;
        tile_remap((int)L, nM, nN, u.pm, u.pn); u.k0 = 0; u.nt = ntk; u.part = 0; return true;
    }
};
struct TailSplitOrder {
    int c, ntk;
    __device__ bool next(int i, Unit& u) const {
        if (i == 0) { tile_remap(c, 36, 8, u.pm, u.pn); u.k0 = 0; u.nt = ntk; u.part = 0; return true; }
        if (i > 1) return false;
        const int tt = c >> 3, sl = c & 7, pairs = ntk >> 1, bp = pairs >> 3, rp = pairs & 7;
        tile_remap(256 + tt, 36, 8, u.pm, u.pn);
        const int np = bp + (sl < rp ? 1 : 0), sp = sl * bp + (sl < rp ? sl : rp);
        u.k0 = sp * 2 * BK; u.nt = np * 2; u.part = 1 + sl * 32 + tt; return true;
    }
};
struct BranchOrder {
    int G, c;
    __device__ bool next(int i, Unit& u) const {
        if (i < 3) { int pm, pn; tile_remap(c, 36, 8, pm, pn); u.pm = i * 36 + pm; u.pn = i * 8 + pn; u.k0 = 0; u.nt = 16; u.part = 0; return true; }
        if (i > 3 || c >= 192) return false;
        const int tt = c / 6, s6 = c - tt * 6, n = s6 >> 1, hf = s6 & 1;
        int pm, pn; tile_remap(256 + tt, 36, 8, pm, pn); u.pm = n * 36 + pm; u.pn = n * 8 + pn; u.k0 = hf * 512; u.nt = 8; u.part = 1 + s6 * 32 + tt; return true;
    }
};

template <class Epi, class Sched>
__device__ __forceinline__ void gemm_phase(LAS unsigned char* lds, const Gemm g, const Sched& S, const Epi& E) {
    const int tid = threadIdx.x, wid = __builtin_amdgcn_readfirstlane(tid >> 6), lane = tid & 63, wr = wid >> 2, wc = wid & 3, fr = lane & 15, fq = lane >> 4;
    int K = g.K; asm volatile("" : "+s"(K));
    unsigned voffA[2], voffB[2];
#pragma unroll
    for (int i = 0; i < 2; ++i) { int R, C; stage_rc(tid * 16 + i * 8192, R, C); const int Rb = Epi::PERM ? ((R & ~31) + perm32(R & 31)) : R; voffA[i] = (unsigned)(R * K + C) * 2u; voffB[i] = (unsigned)(Rb * K + C) * 2u; }
    const size_t kstep = (size_t)(BK * 2);
    const size_t hstep = (size_t)HALF * K * 2;
    const size_t tstep = 2 * hstep;
    const unsigned ldsw = (unsigned)wid * 1024u;
    const int aoff = lds_byte(wr * 64 + fr, fq * 8), boff = lds_byte(wc * 32 + fr, fq * 8);
#define PG8_SA(b, h) (((b) * 2 + (h)) * HTB)
#define PG8_SB(b, h) ((4 + (b) * 2 + (h)) * HTB)
#define PG8_STAGE(bufoff, gbase, voff) do { _Pragma("unroll") for (int _i = 0; _i < 2; ++_i) \
        __builtin_amdgcn_global_load_lds((const unsigned*)((const char*)(gbase) + (voff)[_i]), (LAS unsigned*)(lds + (bufoff) + ldsw + _i * 8192), 16, 0, 0); } while (0)
#define PG8_LDA(dst, b, h) do { _Pragma("unroll") for (int m = 0; m < 4; ++m) _Pragma("unroll") for (int k = 0; k < 2; ++k) dst[m][k] = *(const LAS bf16x8*)(lds + PG8_SA(b, h) + aoff + m * 2048 + k * 1024); } while (0)
#define PG8_LDB(dst, b, h) do { _Pragma("unroll") for (int n = 0; n < 2; ++n) _Pragma("unroll") for (int k = 0; k < 2; ++k) dst[n][k] = *(const LAS bf16x8*)(lds + PG8_SB(b, h) + boff + n * 2048 + k * 1024); } while (0)
#define PG8_MMA(ai, bj, At, Bt) do { __builtin_amdgcn_s_setprio(1); _Pragma("unroll") for (int m = 0; m < 4; ++m) _Pragma("unroll") for (int n = 0; n < 2; ++n) _Pragma("unroll") for (int k = 0; k < 2; ++k) \
        acc[ai][bj][m][n] = __builtin_amdgcn_mfma_f32_16x16x32_bf16(Bt[n][k], At[m][k], acc[ai][bj][m][n], 0, 0, 0); __builtin_amdgcn_s_setprio(0); } while (0)
#define PG8_WAIT_V(n) asm volatile("s_waitcnt vmcnt(" #n ")" ::: "memory")
#define PG8_WAIT_L(n) asm volatile("s_waitcnt lgkmcnt(" #n ")" ::: "memory")
#define PG8_BAR __builtin_amdgcn_s_barrier()
#define PG8_SCHED __builtin_amdgcn_sched_barrier(0)
    Unit cur, nxt; int ui = 0;
    if (!S.next(0, cur)) return;
    f32x4 acc[2][2][4][2];
#pragma unroll
    for (int a = 0; a < 2; ++a)
#pragma unroll
        for (int b = 0; b < 2; ++b)
#pragma unroll
            for (int m = 0; m < 4; ++m)
#pragma unroll
                for (int n = 0; n < 2; ++n) acc[a][b][m][n] = (f32x4){0.f, 0.f, 0.f, 0.f};
    bf16x8 At[4][2], B0[2][2], B1[2][2];
    const char* cA = (const char*)g.A + (size_t)cur.pm * tstep + (size_t)cur.k0 * 2; const char* cB = (const char*)g.Bt + (size_t)cur.pn * tstep + (size_t)cur.k0 * 2;
    PG8_STAGE(PG8_SB(0, 0), cB, voffB); PG8_STAGE(PG8_SA(0, 0), cA, voffA); PG8_STAGE(PG8_SB(0, 1), cB + hstep, voffB); PG8_STAGE(PG8_SA(0, 1), cA + hstep, voffA);
    if (wr == 1) PG8_BAR;
    PG8_WAIT_V(4); PG8_BAR;
    PG8_STAGE(PG8_SB(1, 0), cB + kstep, voffB); PG8_STAGE(PG8_SA(1, 0), cA + kstep, voffA); PG8_STAGE(PG8_SB(1, 1), cB + hstep + kstep, voffB);
    PG8_WAIT_V(6); PG8_BAR;
    for (;;) {
        const bool has_next = S.next(ui + 1, nxt);
        const char* nA = has_next ? (const char*)g.A + (size_t)nxt.pm * tstep + (size_t)nxt.k0 * 2 : cA; const char* nB = has_next ? (const char*)g.Bt + (size_t)nxt.pn * tstep + (size_t)nxt.k0 * 2 : cB;
        const int nt = cur.nt;
        for (int t = 0; t < nt; t += 2) {
            const bool last = (t == nt - 2);
            const char* a1 = cA + (size_t)(t + 1) * kstep;
            const char* a2 = last ? nA : cA + (size_t)(t + 2) * kstep; const char* b2 = last ? nB : cB + (size_t)(t + 2) * kstep;
            const char* a3 = a2 + kstep; const char* b3 = b2 + kstep;
            PG8_LDB(B0, 0, 0); PG8_SCHED; PG8_LDA(At, 0, 0); PG8_STAGE(PG8_SA(1, 1), a1 + hstep, voffA);
            PG8_WAIT_L(8); PG8_BAR; PG8_WAIT_L(0); PG8_MMA(0, 0, At, B0); PG8_BAR; PG8_SCHED;
            PG8_LDB(B1, 0, 1); PG8_STAGE(PG8_SB(0, 0), b2, voffB);
            PG8_BAR; PG8_WAIT_L(0); PG8_MMA(0, 1, At, B1); PG8_BAR;
            PG8_LDA(At, 0, 1); PG8_STAGE(PG8_SA(0, 0), a2, voffA);
            PG8_BAR; PG8_WAIT_L(0); PG8_MMA(1, 0, At, B0); PG8_BAR; PG8_SCHED;
            PG8_STAGE(PG8_SB(0, 1), b2 + hstep, voffB);
            PG8_WAIT_V(6); PG8_BAR; PG8_MMA(1, 1, At, B1); PG8_BAR;
            PG8_LDB(B0, 1, 0); PG8_SCHED; PG8_LDA(At, 1, 0); PG8_STAGE(PG8_SA(0, 1), a2 + hstep, voffA);
            PG8_WAIT_L(8); PG8_BAR; PG8_WAIT_L(0); PG8_MMA(0, 0, At, B0); PG8_BAR; PG8_SCHED;
            PG8_LDB(B1, 1, 1); PG8_STAGE(PG8_SB(1, 0), b3, voffB);
            PG8_BAR; PG8_WAIT_L(0); PG8_MMA(0, 1, At, B1); PG8_BAR;
            PG8_LDA(At, 1, 1); PG8_STAGE(PG8_SA(1, 0), a3, voffA);
            PG8_BAR; PG8_WAIT_L(0); PG8_MMA(1, 0, At, B0); PG8_BAR; PG8_SCHED;
            PG8_STAGE(PG8_SB(1, 1), b3 + hstep, voffB);
            PG8_WAIT_V(6); PG8_BAR; PG8_MMA(1, 1, At, B1); PG8_BAR;
        }
        E(acc, cur, wr, wc, fr, fq);
        if (!has_next) break;
        if (!E.keep(cur)) {
#pragma unroll
        for (int a = 0; a < 2; ++a)
#pragma unroll
            for (int b = 0; b < 2; ++b)
#pragma unroll
                for (int m = 0; m < 4; ++m)
#pragma unroll
                    for (int n = 0; n < 2; ++n) acc[a][b][m][n] = (f32x4){0.f, 0.f, 0.f, 0.f};
        }
        cur = nxt; cA = nA; cB = nB; ++ui;
    }
    PG8_WAIT_V(0);
    if (wr == 0) PG8_BAR;
    PG8_BAR;
#undef PG8_SA
#undef PG8_SB
#undef PG8_STAGE
#undef PG8_LDA
#undef PG8_LDB
#undef PG8_MMA
#undef PG8_WAIT_V
#undef PG8_WAIT_L
#undef PG8_BAR
#undef PG8_SCHED
}
}
using pg8::Unit;

__device__ __forceinline__ void st_bf16x4(bf16_t* dst, f32x4 v) { uint2 o; o.x = cvt_pk_bf16(v[0], v[1]); o.y = cvt_pk_bf16(v[2], v[3]); *(uint2*)dst = o; }

struct EpiProj {
    static constexpr bool PERM = true;
    float* RW; bf16_t* U; float* GV; bf16_t* Q; bf16_t* GT; float* out;
    __device__ __forceinline__ bool keep(const Unit&) const { return false; }
    __device__ __forceinline__ void operator()(f32x4 (&acc)[2][2][4][2], const Unit& u, int wr, int wc, int fr, int fq) const {
        const int pn = u.pn, row0 = u.pm * 256 + wr * 64 + fr, cl0 = wc * 32 + 8 * fq;
#pragma unroll
        for (int ai = 0; ai < 2; ++ai)
#pragma unroll
            for (int m = 0; m < 4; ++m) {
                const int row = row0 + 128 * ai + 16 * m;
                if (pn < 13) {
                    float* dst = RW + (size_t)row * NSH + pn * 256 + cl0;
                    float* sh = nullptr;
                    if (row < NP) { if ((row & 2047) == 2047) sh = out + O_SHP + (size_t)(row >> 11) * NSH; }
                    else { const int q = row - NP; if ((q & 7) == 7) sh = out + O_SHS + (size_t)(q >> 3) * NSH; }
#pragma unroll
                    for (int bj = 0; bj < 2; ++bj)
#pragma unroll
                        for (int n = 0; n < 2; ++n) {
                            *(f32x4*)(dst + 128 * bj + 4 * n) = acc[ai][bj][m][n];
                            if (sh) *(f32x4*)(sh + pn * 256 + cl0 + 128 * bj + 4 * n) = acc[ai][bj][m][n];
                        }
                } else if (pn >= 17 && pn < 21) {
                    float* dst = GV + (size_t)row * 1024 + (pn - 17) * 256 + cl0;
#pragma unroll
                    for (int bj = 0; bj < 2; ++bj)
#pragma unroll
                        for (int n = 0; n < 2; ++n) { f32x4 v = acc[ai][bj][m][n]; for (int j = 0; j < 4; ++j) v[j] = gelu_t(v[j]); *(f32x4*)(dst + 128 * bj + 4 * n) = v; }
                } else if (pn < 17) {
                    bf16_t* dst = U + (size_t)row * 1024 + (pn - 13) * 256 + cl0;
#pragma unroll
                    for (int bj = 0; bj < 2; ++bj) {
                        f32x4 v0 = acc[ai][bj][m][0], v1 = acc[ai][bj][m][1];
                        for (int j = 0; j < 4; ++j) { v0[j] = gelu_t(v0[j]); v1[j] = gelu_t(v1[j]); }
                        uint4 o; o.x = cvt_pk_bf16(v0[0], v0[1]); o.y = cvt_pk_bf16(v0[2], v0[3]); o.z = cvt_pk_bf16(v1[0], v1[1]); o.w = cvt_pk_bf16(v1[2], v1[3]);
                        *(uint4*)(dst + 128 * bj) = o;
                    }
                } else if (pn < 25) {
                    bf16_t* dst = Q + (size_t)row * 1024 + (pn - 21) * 256 + cl0;
#pragma unroll
                    for (int bj = 0; bj < 2; ++bj) {
                        const f32x4 v0 = acc[ai][bj][m][0], v1 = acc[ai][bj][m][1];
                        uint4 o; o.x = cvt_pk_bf16(v0[0], v0[1]); o.y = cvt_pk_bf16(v0[2], v0[3]); o.z = cvt_pk_bf16(v1[0], v1[1]); o.w = cvt_pk_bf16(v1[2], v1[3]);
                        *(uint4*)(dst + 128 * bj) = o;
                    }
                } else {
                    bf16_t* dst = GT + (size_t)row * 6144 + (pn - 25) * 256 + cl0;
#pragma unroll
                    for (int bj = 0; bj < 2; ++bj) {
                        f32x4 v0 = acc[ai][bj][m][0], v1 = acc[ai][bj][m][1];
                        for (int j = 0; j < 4; ++j) { v0[j] = sigm(v0[j]); v1[j] = sigm(v1[j]); }
                        uint4 o; o.x = cvt_pk_bf16(v0[0], v0[1]); o.y = cvt_pk_bf16(v0[2], v0[3]); o.z = cvt_pk_bf16(v1[0], v1[1]); o.w = cvt_pk_bf16(v1[2], v1[3]);
                        *(uint4*)(dst + 128 * bj) = o;
                    }
                }
            }
    }
};
struct EpiMem {
    static constexpr bool PERM = false;
    float* out; bf16_t* MKB; bf16_t* MVT;
    __device__ __forceinline__ bool keep(const Unit&) const { return false; }
    __device__ __forceinline__ void operator()(f32x4 (&acc)[2][2][4][2], const Unit& u, int wr, int wc, int fr, int fq) const {
        const int pn = u.pn, row0 = u.pm * 256 + wr * 64 + fr, cl0 = wc * 32 + 4 * fq;
#pragma unroll
        for (int ai = 0; ai < 2; ++ai)
#pragma unroll
            for (int m = 0; m < 4; ++m) {
                const int row = row0 + 128 * ai + 16 * m;
#pragma unroll
                for (int bj = 0; bj < 2; ++bj)
#pragma unroll
                    for (int n = 0; n < 2; ++n) {
                        const f32x4 v = acc[ai][bj][m][n];
                        if (pn < 4) {
                            const size_t idx = (size_t)row * 1024 + pn * 256 + cl0 + 128 * bj + 16 * n;
                            *(f32x4*)(out + O_MK + idx) = v; st_bf16x4(MKB + idx, v);
                        } else {
                            const int col = (pn - 4) * 256 + cl0 + 128 * bj + 16 * n;
                            *(f32x4*)(out + O_MV + (size_t)row * 1024 + col) = v;
                            const int b = row >> 8, mm = row & 255, h = col >> 8, d = col & 255;
                            bf16_t* t = MVT + ((size_t)((b * 4 + h) * 256 + d)) * 256 + mm;
                            for (int j = 0; j < 4; ++j) t[j * 256] = f2bf(v[j]);
                        }
                    }
            }
    }
};
struct EpiBranch {
    static constexpr bool PERM = true;
    const bf16_t* GT; bf16_t* MIXSUM;
    float* PART;
    __device__ __forceinline__ bool keep(const Unit& u) const { return !u.part && (u.pm / 36) < 2; }
    __device__ __forceinline__ void operator()(f32x4 (&acc)[2][2][4][2], const Unit& u, int wr, int wc, int fr, int fq) const {
        const int nb = u.pm / 36, pm = u.pm - nb * 36, pn = u.pn - nb * 8;
        const int row0 = pm * 256 + wr * 64 + fr, col0 = pn * 256 + wc * 32 + 8 * fq;
        const bool chain = nb < 2 && !u.part;
#pragma unroll
        for (int am = 0; am < 4; ++am) {
            const int ai = am >> 1, mb = (am & 1) * 2;
            uint4 ga[4][2], gb[4][2];
#pragma unroll
            for (int m = mb; m < mb + 2; ++m) {
                const bf16_t* gp = GT + (size_t)(row0 + 128 * ai + 16 * m) * 6144 + nb * 2048 + col0;
#pragma unroll
                for (int bj = 0; bj < 2; ++bj) { ga[m][bj] = *(const uint4*)(gp + 128 * bj); gb[m][bj] = chain ? *(const uint4*)(gp + 2048 + 128 * bj) : ga[m][bj]; }
            }
#pragma unroll
            for (int m = mb; m < mb + 2; ++m) {
                const int row = row0 + 128 * ai + 16 * m;
#pragma unroll
                for (int bj = 0; bj < 2; ++bj) {
                    f32x4 v0 = acc[ai][bj][m][0], v1 = acc[ai][bj][m][1];
                    const uint4 A = ga[m][bj], B = gb[m][bj];
                    if (chain) {
                        v0[0] *= bflo(A.x) * __builtin_amdgcn_rcpf(bflo(B.x)); v0[1] *= bfhi(A.x) * __builtin_amdgcn_rcpf(bfhi(B.x));
                        v0[2] *= bflo(A.y) * __builtin_amdgcn_rcpf(bflo(B.y)); v0[3] *= bfhi(A.y) * __builtin_amdgcn_rcpf(bfhi(B.y));
                        v1[0] *= bflo(A.z) * __builtin_amdgcn_rcpf(bflo(B.z)); v1[1] *= bfhi(A.z) * __builtin_amdgcn_rcpf(bfhi(B.z));
                        v1[2] *= bflo(A.w) * __builtin_amdgcn_rcpf(bflo(B.w)); v1[3] *= bfhi(A.w) * __builtin_amdgcn_rcpf(bfhi(B.w));
                        acc[ai][bj][m][0] = v0; acc[ai][bj][m][1] = v1;
                    } else {
                        v0[0] *= bflo(A.x); v0[1] *= bfhi(A.x); v0[2] *= bflo(A.y); v0[3] *= bfhi(A.y);
                        v1[0] *= bflo(A.z); v1[1] *= bfhi(A.z); v1[2] *= bflo(A.w); v1[3] *= bfhi(A.w);
                        if (u.part) {
                            float* q = PART + ((size_t)(u.part - 1) * 256 + (wr * 64 + fr + 128 * ai + 16 * m)) * 256 + wc * 32 + 8 * fq + 128 * bj;
                            *(f32x4*)q = v0; *(f32x4*)(q + 4) = v1;
                        } else {
                            uint4 o; o.x = cvt_pk_bf16(v0[0], v0[1]); o.y = cvt_pk_bf16(v0[2], v0[3]); o.z = cvt_pk_bf16(v1[0], v1[1]); o.w = cvt_pk_bf16(v1[2], v1[3]);
                            *(uint4*)(MIXSUM + (size_t)row * 2048 + col0 + 128 * bj) = o;
                        }
                    }
                }
            }
        }
    }
};
struct EpiF32 {
    static constexpr bool PERM = true;
    bf16_t* C16; int ldc; float* PART;
    __device__ __forceinline__ bool keep(const Unit&) const { return false; }
    __device__ __forceinline__ void operator()(f32x4 (&acc)[2][2][4][2], const Unit& u, int wr, int wc, int fr, int fq) const {
        if (u.part) {
            float* base = PART + (size_t)(u.part - 1) * 65536 + (size_t)(wr * 64 + fr) * 256 + wc * 32 + 8 * fq;
#pragma unroll
            for (int ai = 0; ai < 2; ++ai)
#pragma unroll
                for (int m = 0; m < 4; ++m) {
                    float* rowp = base + (size_t)(128 * ai + 16 * m) * 256;
#pragma unroll
                    for (int bj = 0; bj < 2; ++bj) { *(f32x4*)(rowp + 128 * bj) = acc[ai][bj][m][0]; *(f32x4*)(rowp + 128 * bj + 4) = acc[ai][bj][m][1]; }
                }
        } else {
            bf16_t* base = C16 + (size_t)(u.pm * 256 + wr * 64 + fr) * ldc + u.pn * 256 + wc * 32 + 8 * fq;
#pragma unroll
            for (int ai = 0; ai < 2; ++ai)
#pragma unroll
                for (int m = 0; m < 4; ++m) {
                    bf16_t* rowp = base + (size_t)(128 * ai + 16 * m) * ldc;
#pragma unroll
                    for (int bj = 0; bj < 2; ++bj) {
                        const f32x4 v0 = acc[ai][bj][m][0], v1 = acc[ai][bj][m][1];
                        uint4 o; o.x = cvt_pk_bf16(v0[0], v0[1]); o.y = cvt_pk_bf16(v0[2], v0[3]); o.z = cvt_pk_bf16(v1[0], v1[1]); o.w = cvt_pk_bf16(v1[2], v1[3]);
                        *(uint4*)(rowp + 128 * bj) = o;
                    }
                }
        }
    }
};
__device__ void reduce_branch_tail(const float* PART, bf16_t* MIXSUM) {
    const int lane = threadIdx.x & 63, gw = blockIdx.x * 8 + (threadIdx.x >> 6), nw = gridDim.x * 8;
    for (int r = gw; r < 32 * 256; r += nw) {
        const int tt = r >> 8, rr = r & 255;
        int pm, pn; pg8::tile_remap(256 + tt, 36, 8, pm, pn);
        f32x4 a = {0.f, 0.f, 0.f, 0.f};
#pragma unroll
        for (int s6 = 0; s6 < 6; ++s6) a += *(const f32x4*)(PART + ((size_t)(s6 * 32 + tt) * 256 + rr) * 256 + lane * 4);
        st_bf16x4(MIXSUM + (size_t)(pm * 256 + rr) * 2048 + pn * 256 + lane * 4, a);
    }
}
__device__ __forceinline__ void build_tailmap(int* tm) {
    for (int i = threadIdx.x; i < 288; i += 512) tm[i] = -1;
    __syncthreads();
    if (threadIdx.x < 32) { int pm, pn; pg8::tile_remap(256 + threadIdx.x, 36, 8, pm, pn); tm[pm * 8 + pn] = threadIdx.x; }
    __syncthreads();
}
__device__ __forceinline__ float4 ld4bf(const bf16_t* q) { const uint2 u = *(const uint2*)q; return make_float4(bflo(u.x), bfhi(u.x), bflo(u.y), bfhi(u.y)); }
__device__ __forceinline__ float4 sum_parts(const float* PART, int tt, int r255, int lane) {
    float4 a = make_float4(0.f, 0.f, 0.f, 0.f);
#pragma unroll
    for (int sl = 0; sl < 8; ++sl) { const float4 x = *(const float4*)(PART + ((size_t)(sl * 32 + tt) * 256 + r255) * 256 + lane * 4); a.x += x.x; a.y += x.y; a.z += x.z; a.w += x.w; }
    return a;
}
struct EpiUp {
    static constexpr bool PERM = true;
    bf16_t* UP; float* out;
    __device__ __forceinline__ bool keep(const Unit&) const { return false; }
    __device__ __forceinline__ void operator()(f32x4 (&acc)[2][2][4][2], const Unit& u, int wr, int wc, int fr, int fq) const {
        const int row0 = u.pm * 256 + wr * 64 + fr, col0 = u.pn * 256 + wc * 32 + 8 * fq;
#pragma unroll
        for (int ai = 0; ai < 2; ++ai)
#pragma unroll
            for (int m = 0; m < 4; ++m) {
                const int row = row0 + 128 * ai + 16 * m;
                float* cs = nullptr;
                if (row < NP) { const int t = row & 2047; if (t >= 2046) cs = out + O_CVP + (size_t)((row >> 11) * 2 + (t - 2046)) * F2; }
                else { const int q = row - NP, t = q & 7; if (t >= 6) cs = out + O_CVS + (size_t)((q >> 3) * 2 + (t - 6)) * F2; }
                bf16_t* rowp = UP + (size_t)row * F2 + col0;
#pragma unroll
                for (int bj = 0; bj < 2; ++bj) {
                    const f32x4 v0 = acc[ai][bj][m][0], v1 = acc[ai][bj][m][1];
                    uint4 o; o.x = cvt_pk_bf16(v0[0], v0[1]); o.y = cvt_pk_bf16(v0[2], v0[3]); o.z = cvt_pk_bf16(v1[0], v1[1]); o.w = cvt_pk_bf16(v1[2], v1[3]);
                    *(uint4*)(rowp + 128 * bj) = o;
                    if (cs) { *(f32x4*)(cs + col0 + 128 * bj) = v0; *(f32x4*)(cs + col0 + 128 * bj + 4) = v1; }
                }
            }
    }
};

struct TcSeg { const float* src; bf16_t* dst; int K, N, tk, tn; };
__device__ __forceinline__ void tconv_seg(const P& p, int gi, TcSeg& g) {
    unsigned char* ws = p.ws; int l;
    if (gi < 6272) { g.src = p.w_in; g.dst = (bf16_t*)(ws + OFF_WIN); g.K = 2048; g.N = 12544; l = gi; }
    else if (gi < 6784) { g.src = p.w_mem_k; g.dst = (bf16_t*)(ws + OFF_WMEM); g.K = 2048; g.N = 1024; l = gi - 6272; }
    else if (gi < 7296) { g.src = p.w_mem_v; g.dst = (bf16_t*)(ws + OFF_WMEM) + (size_t)1024 * 2048; g.K = 2048; g.N = 1024; l = gi - 6784; }
    else if (gi < 8832) { const int nb = (gi - 7296) / 512; g.src = p.w_branch + (size_t)nb * 1024 * 2048; g.dst = (bf16_t*)(ws + OFF_WBR) + (size_t)nb * 2048 * 1024; g.K = 1024; g.N = 2048; l = (gi - 7296) - nb * 512; }
    else if (gi < 9856) { g.src = p.w_out; g.dst = (bf16_t*)(ws + OFF_WOUT); g.K = 2048; g.N = 2048; l = gi - 8832; }
    else if (gi < 15488) { g.src = p.w_up; g.dst = (bf16_t*)(ws + OFF_WUP); g.K = 2048; g.N = F2; l = gi - 9856; }
    else { g.src = p.w_down; g.dst = (bf16_t*)(ws + OFF_WDOWN); g.K = DFF; g.N = 2048; l = gi - 15488; }
    const int ntn = g.N / 64; g.tk = l / ntn; g.tn = l - g.tk * ntn;
}
__device__ __forceinline__ void rms_row_bf16(const float* __restrict__ x, const float* __restrict__ g, bf16_t* __restrict__ o, int lane) {
    float4 v[8]; float ss = 0.f;
#pragma unroll
    for (int i = 0; i < 8; ++i) { v[i] = *(const float4*)(x + (i * 64 + lane) * 4); ss += v[i].x * v[i].x + v[i].y * v[i].y + v[i].z * v[i].z + v[i].w * v[i].w; }
    ss = wsum(ss);
    const float r = rsqrtf(ss * (1.f / 2048.f) + 1e-6f);
#pragma unroll
    for (int i = 0; i < 8; ++i) {
        const float4 gg = *(const float4*)(g + (i * 64 + lane) * 4);
        uint2 pk; pk.x = cvt_pk_bf16(v[i].x * r * gg.x, v[i].y * r * gg.y); pk.y = cvt_pk_bf16(v[i].z * r * gg.z, v[i].w * r * gg.w);
        *(uint2*)(o + (i * 64 + lane) * 4) = pk;
    }
}
__device__ void convert_tiles(const P& p, unsigned char* smem, int gi0, int gi1, int bidx, int nblk) {
    float* tile = (float*)smem;
    const int tid = threadIdx.x, kk0 = tid >> 4, n4 = (tid & 15) * 4, nn = tid >> 3, kc = (tid & 7) * 8;
    int gi = gi0 + bidx;
    if (gi >= gi1) return;
    TcSeg g; tconv_seg(p, gi, g);
    float4 v0 = *(const float4*)(g.src + (size_t)(g.tk * 64 + kk0) * g.N + g.tn * 64 + n4), v1 = *(const float4*)(g.src + (size_t)(g.tk * 64 + kk0 + 32) * g.N + g.tn * 64 + n4);
    for (;;) {
        const int gn = gi + nblk; const bool more = gn < gi1;
        TcSeg h = g; float4 u0 = v0, u1 = v1;
        if (more) { tconv_seg(p, gn, h); u0 = *(const float4*)(h.src + (size_t)(h.tk * 64 + kk0) * h.N + h.tn * 64 + n4); u1 = *(const float4*)(h.src + (size_t)(h.tk * 64 + kk0 + 32) * h.N + h.tn * 64 + n4); }
        { float* t = tile + kk0 * 65 + n4; t[0] = v0.x; t[1] = v0.y; t[2] = v0.z; t[3] = v0.w; t += 32 * 65; t[0] = v1.x; t[1] = v1.y; t[2] = v1.z; t[3] = v1.w; }
        __syncthreads();
        uint4 o;
        o.x = cvt_pk_bf16(tile[(kc + 0) * 65 + nn], tile[(kc + 1) * 65 + nn]);
        o.y = cvt_pk_bf16(tile[(kc + 2) * 65 + nn], tile[(kc + 3) * 65 + nn]);
        o.z = cvt_pk_bf16(tile[(kc + 4) * 65 + nn], tile[(kc + 5) * 65 + nn]);
        o.w = cvt_pk_bf16(tile[(kc + 6) * 65 + nn], tile[(kc + 7) * 65 + nn]);
        *(uint4*)(g.dst + (size_t)(g.tn * 64 + nn) * g.K + g.tk * 64 + kc) = o;
        __syncthreads();
        if (!more) break;
        gi = gn; g = h; v0 = u0; v1 = u1;
    }
}
__device__ void phase0(const P& p, unsigned char* smem) {
    unsigned char* ws = p.ws;
    const int G = gridDim.x;
    convert_tiles(p, smem, 0, 7296, blockIdx.x, G);
    {
        bf16_t* wlr = (bf16_t*)(ws + OFF_WLR);
        for (int i = blockIdx.x * 512 + threadIdx.x; i < 256 * 1024; i += G * 512) {
            const int k = i >> 10, c = i & 1023;
            const float v = k < 64 ? p.w_decay[i] : (k < 128 ? p.w_aaa[i - 64 * 1024] : p.w_gate[i - 128 * 1024]);
            wlr[c * 256 + k] = f2bf(v);
        }
    }
    {
        bf16_t* wsb = (bf16_t*)(ws + OFF_WSB);
        for (int i = blockIdx.x * 512 + threadIdx.x; i < 8 * 128 * 128; i += G * 512) {
            const int s = i & 127, t = (i >> 7) & 127;
            wsb[i] = f2bf(s <= t ? p.w_s[i] : 0.f);
        }
    }
    const int lane = threadIdx.x & 63, wv = threadIdx.x >> 6;
    for (int r = blockIdx.x * 8 + wv; r < NTOK + 1024; r += G * 8) {
        if (r < NTOK) {
            const float* x = r < NP ? p.x_p + (size_t)r * 2048 : p.x_s + (size_t)(r - NP) * 2048;
            rms_row_bf16(x, p.g_pre_mix, (bf16_t*)(ws + OFF_XN) + (size_t)r * 2048, lane);
        } else {
            const int q = r - NTOK;
            rms_row_bf16(p.mem_p + (size_t)q * 2048, p.g_mem, (bf16_t*)(ws + OFF_MN) + (size_t)q * 2048, lane);
        }
    }
}

__device__ __forceinline__ float hsum32d(float v) {
    v += dpp_x1(v); v += dpp_x2(v); v += dpp_hm(v);
    v += __int_as_float(__builtin_amdgcn_mov_dpp(__float_as_int(v), 0x140, 0xF, 0xF, true));
    v += __shfl_xor(v, 16);
    return v;
}
__device__ void phase_prep(const P& p, unsigned char* smem) {
    bf16_t* Ab = (bf16_t*)smem;
    float* lro = (float*)(smem + 8448);
    const float* RW = (const float*)(p.ws + OFF_RW);
    float* PREP = (float*)(p.ws + OFF_PREP);
    const float* GV = (const float*)(p.ws + OFF_GV);
    float* LNST = (float*)(p.ws + OFF_LNST);
    const bf16_t* WLR = (const bf16_t*)(p.ws + OFF_WLR);
    const int tid = threadIdx.x, lane = tid & 63, wv = tid >> 6, fr = lane & 15, kg = lane >> 4;
    for (int kt = 0; kt < 3; ++kt) {
        const int cb_ = blockIdx.x; const int ti = kt == 0 ? cb_ : (kt == 1 ? (cb_ < 224 ? 256 + cb_ : -1) : (cb_ < 96 ? 480 + cb_ : -1));
        if (ti < 0) continue;
        const int row0 = ti * 16;
        {
            const bool smp = row0 >= NP;
            float curA[8], prvA[8];
#pragma unroll
            for (int i = 0; i < 8; ++i) {
                const int e = tid + i * 512, t = e >> 8, col = 3072 + (e & 255), row = row0 + t;
                const bool first = smp ? (((row - NP) & 7) == 0) : ((row & 2047) == 0);
                const float* pp = first ? (smp ? p.st_shift + (size_t)((row - NP) >> 3) * NSH : RW + (size_t)row * NSH) : RW + (size_t)(row - 1) * NSH;
                curA[i] = RW[(size_t)row * NSH + col];
                prvA[i] = pp[col];
                if (first && !smp) prvA[i] = 0.f;
            }
#pragma unroll
            for (int i = 0; i < 8; ++i) {
                const int e = tid + i * 512, t = e >> 8, j = e & 255;
                const float s = curA[i] + p.mu[3072 + j] * (prvA[i] - curA[i]);
                Ab[t * 264 + j] = f2bf(j < 64 ? (1.f - 2.f / (__expf(2.f * s) + 1.f)) : (j < 128 ? s : sigm(s)));
            }
        }
        __syncthreads();
#pragma unroll 1
        for (int half = 0; half < 2; ++half) {
            bf16x8 af[8];
#pragma unroll
            for (int ks = 0; ks < 8; ++ks) af[ks] = *(const bf16x8*)(Ab + fr * 264 + 32 * ks + 8 * kg);
#pragma unroll
            for (int nt = 0; nt < 4; ++nt) {
                const bf16_t* wrow = WLR + (size_t)(512 * half + 64 * wv + 16 * nt + fr) * 256 + 8 * kg;
                bf16x8 bfr[8];
#pragma unroll
                for (int ks = 0; ks < 8; ++ks) bfr[ks] = *(const bf16x8*)(wrow + 32 * ks);
                f32x4 ad = {0.f, 0.f, 0.f, 0.f}, aa = ad, ag = ad;
                ad = __builtin_amdgcn_mfma_f32_16x16x32_bf16(af[0], bfr[0], ad, 0, 0, 0); ad = __builtin_amdgcn_mfma_f32_16x16x32_bf16(af[1], bfr[1], ad, 0, 0, 0);
                aa = __builtin_amdgcn_mfma_f32_16x16x32_bf16(af[2], bfr[2], aa, 0, 0, 0); aa = __builtin_amdgcn_mfma_f32_16x16x32_bf16(af[3], bfr[3], aa, 0, 0, 0);
#pragma unroll
                for (int ks = 4; ks < 8; ++ks) ag = __builtin_amdgcn_mfma_f32_16x16x32_bf16(af[ks], bfr[ks], ag, 0, 0, 0);
#pragma unroll
                for (int i = 0; i < 4; ++i) {
                    float* o = lro + (4 * kg + i) * 1536 + 64 * wv + 16 * nt + fr;
                    o[0] = ad[i]; o[512] = aa[i]; o[1024] = ag[i];
                }
            }
            __syncthreads();
            {
                const int cl = 2 * (tid & 255), c0 = 512 * half + cl, tg = tid >> 8, h = c0 >> 6, cc = c0 & 63;
                const f32x2 mur = *(const f32x2*)(p.mu + c0), muk = *(const f32x2*)(p.mu + 1024 + c0), muv = *(const f32x2*)(p.mu + 2048 + c0);
                const f32x2 w0v = *(const f32x2*)(p.w0 + c0), a0v = *(const f32x2*)(p.a0 + c0), kkv = *(const f32x2*)(p.k_k + c0), kav = *(const f32x2*)(p.k_a + c0);
                f32x2 pr = {0.f, 0.f}, pk = pr, pv = pr;
                {
                    const int row = row0 + 8 * tg; const float* pp = nullptr;
                    if (row < NP) { if (row & 2047) pp = RW + (size_t)(row - 1) * NSH; }
                    else { const int q = row - NP; pp = (q & 7) ? RW + (size_t)(row - 1) * NSH : p.st_shift + (size_t)(q >> 3) * NSH; }
                    if (pp) { pr = *(const f32x2*)(pp + c0); pk = *(const f32x2*)(pp + 1024 + c0); pv = *(const f32x2*)(pp + 2048 + c0); }
                }
                f32x2 crA[8], ckA[8], cvA[8];
#pragma unroll
                for (int tt = 0; tt < 8; ++tt) {
                    const float* rwp = RW + (size_t)(row0 + 8 * tg + tt) * NSH;
                    crA[tt] = *(const f32x2*)(rwp + c0); ckA[tt] = *(const f32x2*)(rwp + 1024 + c0); cvA[tt] = *(const f32x2*)(rwp + 2048 + c0);
                }
#pragma unroll
                for (int tt = 0; tt < 8; ++tt) {
                    const int t = 8 * tg + tt;
                    const f32x2 cr = crA[tt], ck = ckA[tt], cv = cvA[tt];
                    const f32x2 r = cr + mur * (pr - cr), k = ck + muk * (pk - ck), v = cv + muv * (pv - cv);
                    pr = cr; pk = ck; pv = cv;
                    const f32x2 dpv = *(const f32x2*)(lro + t * 1536 + cl), apv = *(const f32x2*)(lro + t * 1536 + 512 + cl), gpv = *(const f32x2*)(lro + t * 1536 + 1024 + cl);
                    f32x2 dec, a;
#pragma unroll
                    for (int e = 0; e < 2; ++e) {
                        const float z = -(w0v[e] + dpv[e]);
                        const float sp = fmaxf(z, 0.f) + __logf(1.f + __expf(-fabsf(z)));
                        dec[e] = __expf(-__expf(-sp - 0.5f));
                        a[e] = 1.f / (1.f + __expf(-(a0v[e] + apv[e])));
                    }
                    const f32x2 kk = k * kkv;
                    const float ss = hsum32d(kk[0] * kk[0] + kk[1] * kk[1]);
                    const float inv = 1.f / fmaxf(sqrtf(ss), 1e-12f);
                    const f32x2 kkn = kk * inv;
                    const f32x2 k2 = k * (1.f + (a - 1.f) * kav);
                    float* dst = PREP + ((size_t)(row0 + t) * 16 + h) * 448 + cc;
                    *(f32x2*)(dst) = r; *(f32x2*)(dst + 64) = dec; *(f32x2*)(dst + 128) = k2; *(f32x2*)(dst + 192) = v;
                    *(f32x2*)(dst + 256) = -kkn; *(f32x2*)(dst + 320) = kkn * a; *(f32x2*)(dst + 384) = gpv;
                }
            }
            __syncthreads();
        }
#pragma unroll
        for (int q2 = 0; q2 < 2; ++q2) {
            const int row = row0 + 2 * wv + q2;
            const float* gr = GV + (size_t)row * 1024;
            float4 x[4]; float sm = 0.f;
#pragma unroll
            for (int i = 0; i < 4; ++i) { x[i] = *(const float4*)(gr + (i * 64 + lane) * 4); sm += x[i].x + x[i].y + x[i].z + x[i].w; }
            const float mean = wsum(sm) * (1.f / 1024.f);
            float q = 0.f;
#pragma unroll
            for (int i = 0; i < 4; ++i) { const float a = x[i].x - mean, b = x[i].y - mean, c = x[i].z - mean, d = x[i].w - mean; q += a * a + b * b + c * c + d * d; }
            const float var = wsum(q) * (1.f / 1024.f);
            if (lane == 0) { LNST[(size_t)row * 2] = mean; LNST[(size_t)row * 2 + 1] = rsqrtf(var + 1e-5f); }
        }
    }
}

__device__ __forceinline__ float sum16d(float v) {
    v += dpp_x1(v); v += dpp_x2(v); v += dpp_hm(v);
    v += __int_as_float(__builtin_amdgcn_mov_dpp(__float_as_int(v), 0x140, 0xF, 0xF, true));
    return v;
}
__device__ void scan_seq(const P& p, unsigned char* smem, int row0, int T, int h, const float* s_in, float* s_out) {
    float* buf = (float*)smem;
    float* ybuf = (float*)(smem + 86016);
    const float* PREP = (const float*)(p.ws + OFF_PREP);
    bf16_t* AOUT = (bf16_t*)(p.ws + OFF_BR);
    const int tid = threadIdx.x, lane = tid & 63, wv = tid >> 6, r8 = lane >> 3, kq = lane & 7, row = (wv & 3) * 8 + r8, rowB = row + 32;
    const bool scanw = wv < 4;
    const int htid = tid & 255, ht = htid >> 4, l16 = htid & 15;
    const int TC = T < 16 ? T : 16, nch = T / TC, nf4 = TC * 112;
    f32x2 S0 = {0.f, 0.f}, S1 = S0, S2 = S0, S3 = S0, T0 = S0, T1 = S0, T2 = S0, T3 = S0;
    if (s_in && scanw) {
        const f32x4 a = *(const f32x4*)(s_in + row * 64 + kq * 8), b = *(const f32x4*)(s_in + row * 64 + kq * 8 + 4); S0 = __builtin_shufflevector(a, a, 0, 1); S1 = __builtin_shufflevector(a, a, 2, 3); S2 = __builtin_shufflevector(b, b, 0, 1); S3 = __builtin_shufflevector(b, b, 2, 3);
        const f32x4 c2 = *(const f32x4*)(s_in + rowB * 64 + kq * 8), d2 = *(const f32x4*)(s_in + rowB * 64 + kq * 8 + 4); T0 = __builtin_shufflevector(c2, c2, 0, 1); T1 = __builtin_shufflevector(c2, c2, 2, 3); T2 = __builtin_shufflevector(d2, d2, 0, 1); T3 = __builtin_shufflevector(d2, d2, 2, 3);
    }
    float4 h0, h1, h2, h3, h4, h5, h6;
#define HPF_LOAD1(dst, i, tokbase) { int idx = htid + (i) * 256; idx = idx < nf4 ? idx : nf4 - 1; const int tk = idx / 112, off = idx - tk * 112; dst = *(const float4*)(PREP + ((size_t)((tokbase) + tk) * 16 + h) * 448 + off * 4); }
#define HPF_STORE1(src, i, base) { const int idx = htid + (i) * 256; if (idx < nf4) *(float4*)((base) + idx * 4) = src; }
#define HPF_LOAD(tokbase) { HPF_LOAD1(h0, 0, tokbase) HPF_LOAD1(h1, 1, tokbase) HPF_LOAD1(h2, 2, tokbase) HPF_LOAD1(h3, 3, tokbase) HPF_LOAD1(h4, 4, tokbase) HPF_LOAD1(h5, 5, tokbase) HPF_LOAD1(h6, 6, tokbase) }
#define HPF_STORE(base) { HPF_STORE1(h0, 0, base) HPF_STORE1(h1, 1, base) HPF_STORE1(h2, 2, base) HPF_STORE1(h3, 3, base) HPF_STORE1(h4, 4, base) HPF_STORE1(h5, 5, base) HPF_STORE1(h6, 6, base) }
    float4 lw4 = make_float4(0.f, 0.f, 0.f, 0.f), lb4 = lw4, rk4 = lw4;
    if (!scanw) {
        HPF_LOAD(row0) HPF_STORE(buf)
        if (nch > 1) HPF_LOAD(row0 + TC)
        lw4 = *(const float4*)(p.lnx_w + h * 64 + 4 * l16); lb4 = *(const float4*)(p.lnx_b + h * 64 + 4 * l16); rk4 = *(const float4*)(p.r_k + h * 64 + 4 * l16);
    }
    __syncthreads();
#define LO2(v) __builtin_shufflevector(v, v, 0, 1)
#define HI2(v) __builtin_shufflevector(v, v, 2, 3)
#define ST_LOAD(X, i) { const int ii_ = (i) < TC ? (i) : TC - 1; const float* b_ = cb + ii_ * 448 + kq * 8; \
            X##w0 = *(const f32x4*)(b_ + 64); X##w1 = *(const f32x4*)(b_ + 68); X##a0 = *(const f32x4*)(b_ + 256); X##a1 = *(const f32x4*)(b_ + 260); \
            X##b0 = *(const f32x4*)(b_ + 320); X##b1 = *(const f32x4*)(b_ + 324); X##k0 = *(const f32x4*)(b_ + 128); X##k1 = *(const f32x4*)(b_ + 132); \
            X##q0 = *(const f32x4*)(b_); X##q1 = *(const f32x4*)(b_ + 4); X##vr = cb[ii_ * 448 + 192 + row]; X##vs = cb[ii_ * 448 + 192 + rowB]; }
#define ST_STEP(X, i) { f32x2 ac_ = S0 * LO2(X##a0); ac_ = S1 * HI2(X##a0) + ac_; ac_ = S2 * LO2(X##a1) + ac_; ac_ = S3 * HI2(X##a1) + ac_; \
            f32x2 bc_ = T0 * LO2(X##a0); bc_ = T1 * HI2(X##a0) + bc_; bc_ = T2 * LO2(X##a1) + bc_; bc_ = T3 * HI2(X##a1) + bc_; \
            const float sa_ = red8(ac_[0] + ac_[1]), sb_ = red8(bc_[0] + bc_[1]); const f32x2 sv_ = {sa_, sa_}, vv_ = {X##vr, X##vr}, sw_ = {sb_, sb_}, vw_ = {X##vs, X##vs}; \
            S0 = S0 * LO2(X##w0) + (sv_ * LO2(X##b0) + vv_ * LO2(X##k0)); S1 = S1 * HI2(X##w0) + (sv_ * HI2(X##b0) + vv_ * HI2(X##k0)); \
            S2 = S2 * LO2(X##w1) + (sv_ * LO2(X##b1) + vv_ * LO2(X##k1)); S3 = S3 * HI2(X##w1) + (sv_ * HI2(X##b1) + vv_ * HI2(X##k1)); \
            T0 = T0 * LO2(X##w0) + (sw_ * LO2(X##b0) + vw_ * LO2(X##k0)); T1 = T1 * HI2(X##w0) + (sw_ * HI2(X##b0) + vw_ * HI2(X##k0)); \
            T2 = T2 * LO2(X##w1) + (sw_ * LO2(X##b1) + vw_ * LO2(X##k1)); T3 = T3 * HI2(X##w1) + (sw_ * HI2(X##b1) + vw_ * HI2(X##k1)); \
            f32x2 ya_ = S0 * LO2(X##q0); ya_ = S1 * HI2(X##q0) + ya_; ya_ = S2 * LO2(X##q1) + ya_; ya_ = S3 * HI2(X##q1) + ya_; \
            f32x2 yb_ = T0 * LO2(X##q0); yb_ = T1 * HI2(X##q0) + yb_; yb_ = T2 * LO2(X##q1) + yb_; yb_ = T3 * HI2(X##q1) + yb_; \
            float y1_ = ya_[0] + ya_[1], y2_ = yb_[0] + yb_[1]; y1_ += dpp_x1(y1_); y2_ += dpp_x1(y2_); y1_ += dpp_x2(y1_); y2_ += dpp_x2(y2_); \
            if ((kq & 3) == 0) { yb[(i) * 128 + row * 2 + (kq >> 2)] = y1_; yb[(i) * 128 + rowB * 2 + (kq >> 2)] = y2_; } }
    for (int c = 0; c < nch; ++c) {
        if (scanw) {
            const float* cb = buf + (c % 3) * (16 * 448);
            float* yb = ybuf + (c & 1) * 2048;
            f32x4 Aw0, Aw1, Aa0, Aa1, Ab0, Ab1, Ak0, Ak1, Aq0, Aq1, Bw0, Bw1, Ba0, Ba1, Bb0, Bb1, Bk0, Bk1, Bq0, Bq1; float Avr, Bvr, Avs, Bvs;
            ST_LOAD(A, 0)
            for (int i = 0; i < TC; i += 2) {
                ST_LOAD(B, i + 1)
                ST_STEP(A, i)
                ST_LOAD(A, i + 2)
                ST_STEP(B, i + 1)
            }
        } else {
            if (c + 1 < nch) { float* nb = buf + ((c + 1) % 3) * (16 * 448); HPF_STORE(nb) }
            if (c + 2 < nch) HPF_LOAD(row0 + (c + 2) * TC)
        }
        if (!scanw && c >= 1) {
#define SCAN_POST(cc) { const float* cbp = buf + ((cc) % 3) * (16 * 448); const float* ybp = ybuf + ((cc) & 1) * 2048; \
            if (ht < TC) { const float* tb = cbp + ht * 448; \
                const float4 pa = *(const float4*)(ybp + ht * 128 + 8 * l16), pb = *(const float4*)(ybp + ht * 128 + 8 * l16 + 4); \
                const float y0 = pa.x + pa.y, y1 = pa.z + pa.w, y2 = pb.x + pb.y, y3 = pb.z + pb.w; \
                const float mean = sum16d((y0 + y1) + (y2 + y3)) * (1.f / 64.f); \
                const float d0 = y0 - mean, d1 = y1 - mean, d2 = y2 - mean, d3 = y3 - mean; \
                const float rs = rsqrtf(sum16d((d0 * d0 + d1 * d1) + (d2 * d2 + d3 * d3)) * (1.f / 64.f) + 64e-5f); \
                const float4 r4 = *(const float4*)(tb + 4 * l16), k4 = *(const float4*)(tb + 128 + 4 * l16), v4 = *(const float4*)(tb + 192 + 4 * l16), g4 = *(const float4*)(tb + 384 + 4 * l16); \
                const float bon = sum16d((r4.x * k4.x * rk4.x + r4.y * k4.y * rk4.y) + (r4.z * k4.z * rk4.z + r4.w * k4.w * rk4.w)); \
                uint2 o; o.x = cvt_pk_bf16((d0 * rs * lw4.x + lb4.x + bon * v4.x) * g4.x, (d1 * rs * lw4.y + lb4.y + bon * v4.y) * g4.y); \
                o.y = cvt_pk_bf16((d2 * rs * lw4.z + lb4.z + bon * v4.z) * g4.z, (d3 * rs * lw4.w + lb4.w + bon * v4.w) * g4.w); \
                *(uint2*)(AOUT + (size_t)(row0 + (cc) * TC + ht) * 1024 + h * 64 + 4 * l16) = o; } }
            SCAN_POST(c - 1)
        }
        __syncthreads();
    }
    if (!scanw) SCAN_POST(nch - 1)
    if (scanw) {
        float4 a, b; a.x = S0[0]; a.y = S0[1]; a.z = S1[0]; a.w = S1[1]; b.x = S2[0]; b.y = S2[1]; b.z = S3[0]; b.w = S3[1];
        *(float4*)(s_out + row * 64 + kq * 8) = a; *(float4*)(s_out + row * 64 + kq * 8 + 4) = b;
        a.x = T0[0]; a.y = T0[1]; a.z = T1[0]; a.w = T1[1]; b.x = T2[0]; b.y = T2[1]; b.z = T3[0]; b.w = T3[1];
        *(float4*)(s_out + rowB * 64 + kq * 8) = a; *(float4*)(s_out + rowB * 64 + kq * 8 + 4) = b;
    }
    __syncthreads();
}

template <bool SAMPLE>
__device__ void attn_item(const P& p, unsigned char* smem, int b, int h, int r0) {
    constexpr int MT = SAMPLE ? 1 : 2;
    float* Sb = (float*)smem;
    bf16_t* Pb = (bf16_t*)(smem + 33280);
    const bf16_t* Q = (const bf16_t*)(p.ws + OFF_Q);
    const bf16_t* MKB = (const bf16_t*)(p.ws + OFF_MKB);
    const bf16_t* MVT = (const bf16_t*)(p.ws + OFF_MVT);
    bf16_t* COUT = (bf16_t*)(p.ws + OFF_BR) + (size_t)2 * NTOK * 1024;
    const int tid = threadIdx.x, lane = tid & 63, wv = tid >> 6, fr = lane & 15, kg = lane >> 4;
    bf16x8 qa[MT][8];
#pragma unroll
    for (int mt = 0; mt < MT; ++mt) {
        const int rq = SAMPLE ? r0 + (fr & 7) : r0 + 16 * mt + fr;
#pragma unroll
        for (int ks = 0; ks < 8; ++ks) qa[mt][ks] = *(const bf16x8*)(Q + (size_t)rq * 1024 + h * 256 + 32 * ks + 8 * kg);
    }
    f32x4 acc[MT][2];
#pragma unroll
    for (int mt = 0; mt < MT; ++mt) { acc[mt][0] = (f32x4){0.f, 0.f, 0.f, 0.f}; acc[mt][1] = acc[mt][0]; }
#pragma unroll
    for (int nt = 0; nt < 2; ++nt) {
        const int mrow = 32 * wv + 16 * nt + fr;
#pragma unroll
        for (int ks = 0; ks < 8; ++ks) {
            bf16x8 bf;
            if (SAMPLE) {
                const float* kp = p.ck + ((size_t)(b * 256 + mrow)) * 1024 + h * 256 + 32 * ks + 8 * kg;
                const float4 x = *(const float4*)kp, y = *(const float4*)(kp + 4);
                union { bf16x8 v; unsigned u[4]; } cvt;
                cvt.u[0] = cvt_pk_bf16(x.x, x.y); cvt.u[1] = cvt_pk_bf16(x.z, x.w); cvt.u[2] = cvt_pk_bf16(y.x, y.y); cvt.u[3] = cvt_pk_bf16(y.z, y.w);
                bf = cvt.v;
            } else {
                bf = *(const bf16x8*)(MKB + ((size_t)(b * 256 + mrow)) * 1024 + h * 256 + 32 * ks + 8 * kg);
            }
#pragma unroll
            for (int mt = 0; mt < MT; ++mt) acc[mt][nt] = __builtin_amdgcn_mfma_f32_16x16x32_bf16(qa[mt][ks], bf, acc[mt][nt], 0, 0, 0);
        }
    }
#pragma unroll
    for (int mt = 0; mt < MT; ++mt)
#pragma unroll
        for (int nt = 0; nt < 2; ++nt)
#pragma unroll
            for (int i = 0; i < 4; ++i) Sb[(16 * mt + 4 * kg + i) * 260 + 32 * wv + 16 * nt + fr] = acc[mt][nt][i] * 0.0625f;
    __syncthreads();
    for (int rr = wv; rr < 16 * MT; rr += 8) {
        const float4 s = *(const float4*)(Sb + rr * 260 + lane * 4);
        const float mx = wmaxf(fmaxf(fmaxf(s.x, s.y), fmaxf(s.z, s.w)));
        const float e0 = __expf(s.x - mx), e1 = __expf(s.y - mx), e2 = __expf(s.z - mx), e3 = __expf(s.w - mx);
        const float inv = 1.f / wsum(e0 + e1 + e2 + e3);
        uint2 pk; pk.x = cvt_pk_bf16(e0 * inv, e1 * inv); pk.y = cvt_pk_bf16(e2 * inv, e3 * inv);
        *(uint2*)(Pb + rr * 264 + lane * 4) = pk;
    }
    __syncthreads();
#pragma unroll
    for (int mt = 0; mt < MT; ++mt) { acc[mt][0] = (f32x4){0.f, 0.f, 0.f, 0.f}; acc[mt][1] = acc[mt][0]; }
    if (SAMPLE) {
        const float* vbase = p.cv + ((size_t)(b * 256 + 8 * kg)) * 1024 + h * 256 + 32 * wv + fr;
#pragma unroll 1
        for (int ks = 0; ks < 8; ++ks) {
            const float* vp = vbase + (size_t)ks * 32 * 1024;
            float x0[8], x1[8];
#pragma unroll
            for (int j = 0; j < 8; ++j) { x0[j] = vp[(size_t)j * 1024]; x1[j] = vp[(size_t)j * 1024 + 16]; }
            union { bf16x8 v; unsigned u[4]; } c0, c1;
#pragma unroll
            for (int j = 0; j < 4; ++j) { c0.u[j] = cvt_pk_bf16(x0[2 * j], x0[2 * j + 1]); c1.u[j] = cvt_pk_bf16(x1[2 * j], x1[2 * j + 1]); }
            const bf16x8 pa = *(const bf16x8*)(Pb + fr * 264 + 32 * ks + 8 * kg);
            acc[0][0] = __builtin_amdgcn_mfma_f32_16x16x32_bf16(pa, c0.v, acc[0][0], 0, 0, 0);
            acc[0][1] = __builtin_amdgcn_mfma_f32_16x16x32_bf16(pa, c1.v, acc[0][1], 0, 0, 0);
        }
    } else {
#pragma unroll
        for (int nt = 0; nt < 2; ++nt) {
            const int dcol = 32 * wv + 16 * nt + fr;
#pragma unroll
            for (int ks = 0; ks < 8; ++ks) {
                const bf16x8 bf = *(const bf16x8*)(MVT + ((size_t)((b * 4 + h) * 256 + dcol)) * 256 + 32 * ks + 8 * kg);
#pragma unroll
                for (int mt = 0; mt < MT; ++mt) {
                    const bf16x8 pa = *(const bf16x8*)(Pb + (16 * mt + fr) * 264 + 32 * ks + 8 * kg);
                    acc[mt][nt] = __builtin_amdgcn_mfma_f32_16x16x32_bf16(pa, bf, acc[mt][nt], 0, 0, 0);
                }
            }
        }
    }
#pragma unroll
    for (int mt = 0; mt < MT; ++mt)
#pragma unroll
        for (int nt = 0; nt < 2; ++nt)
#pragma unroll
            for (int i = 0; i < 4; ++i) {
                const int rl = 16 * mt + 4 * kg + i;
                if (!SAMPLE || rl < 8) COUT[(size_t)(r0 + rl) * 1024 + h * 256 + 32 * wv + 16 * nt + fr] = f2bf(acc[mt][nt][i]);
            }
    __syncthreads();
}

__device__ void sgu_prompt_item(const P& p, unsigned char* smem, int b, int ch, int g) {
    bf16_t* VT = (bf16_t*)smem;
    const float* GV = (const float*)(p.ws + OFF_GV);
    const float* LNST = (const float*)(p.ws + OFF_LNST);
    const bf16_t* WSB = (const bf16_t*)(p.ws + OFF_WSB);
    const bf16_t* U = (const bf16_t*)(p.ws + OFF_U);
    bf16_t* BOUT = (bf16_t*)(p.ws + OFF_BR) + (size_t)NTOK * 1024;
    const int tid = threadIdx.x, lane = tid & 63, wv = tid >> 6, fr = lane & 15, kg = lane >> 4;
    const int row0 = b * 2048 + ch * 128;
    {
        const int s = tid >> 2, c0 = (tid & 3) * 32;
        const float mean = LNST[(size_t)(row0 + s) * 2], rstd = LNST[(size_t)(row0 + s) * 2 + 1];
#pragma unroll
        for (int q = 0; q < 8; ++q) {
            const float4 x = *(const float4*)(GV + (size_t)(row0 + s) * 1024 + g * 128 + c0 + 4 * q);
            const float4 gm = *(const float4*)(p.sgu_g + g * 128 + c0 + 4 * q), bt = *(const float4*)(p.sgu_b + g * 128 + c0 + 4 * q);
            VT[(c0 + 4 * q + 0) * 136 + s] = f2bf((x.x - mean) * rstd * gm.x + bt.x);
            VT[(c0 + 4 * q + 1) * 136 + s] = f2bf((x.y - mean) * rstd * gm.y + bt.y);
            VT[(c0 + 4 * q + 2) * 136 + s] = f2bf((x.z - mean) * rstd * gm.z + bt.z);
            VT[(c0 + 4 * q + 3) * 136 + s] = f2bf((x.w - mean) * rstd * gm.w + bt.w);
        }
    }
    __syncthreads();
    const int t0 = 16 * wv;
    f32x4 acc[8];
#pragma unroll
    for (int nt = 0; nt < 8; ++nt) acc[nt] = (f32x4){0.f, 0.f, 0.f, 0.f};
#pragma unroll
    for (int ks = 0; ks < 4; ++ks) {
        if (32 * ks <= t0 + 15) {
            const bf16x8 af = *(const bf16x8*)(WSB + (size_t)(g * 128 + t0 + fr) * 128 + 32 * ks + 8 * kg);
#pragma unroll
            for (int nt = 0; nt < 8; ++nt) {
                const bf16x8 bf = *(const bf16x8*)(VT + (16 * nt + fr) * 136 + 32 * ks + 8 * kg);
                acc[nt] = __builtin_amdgcn_mfma_f32_16x16x32_bf16(af, bf, acc[nt], 0, 0, 0);
            }
        }
    }
#pragma unroll
    for (int i = 0; i < 4; ++i) {
        const int t = t0 + 4 * kg + i;
        const float bs = p.b_s[g * 128 + t];
#pragma unroll
        for (int nt = 0; nt < 8; ++nt) {
            const size_t idx = (size_t)(row0 + t) * 1024 + g * 128 + 16 * nt + fr;
            BOUT[idx] = f2bf(bf2f(U[idx]) * (acc[nt][i] + bs));
        }
    }
    __syncthreads();
}
__device__ void sgu_sample_item(const P& p, int b) {
    const float* GV = (const float*)(p.ws + OFF_GV);
    const float* LNST = (const float*)(p.ws + OFF_LNST);
    const bf16_t* U = (const bf16_t*)(p.ws + OFF_U);
    bf16_t* BOUT = (bf16_t*)(p.ws + OFF_BR) + (size_t)NTOK * 1024;
    const int c0 = 2 * threadIdx.x, g = c0 >> 7, row0 = NP + b * 8;
    const float2 gm = *(const float2*)(p.sgu_g + c0), bt = *(const float2*)(p.sgu_b + c0);
    float2 v[8];
#pragma unroll
    for (int s = 0; s < 8; ++s) {
        const float mean = LNST[(size_t)(row0 + s) * 2], rstd = LNST[(size_t)(row0 + s) * 2 + 1];
        const float2 x = *(const float2*)(GV + (size_t)(row0 + s) * 1024 + c0);
        v[s].x = (x.x - mean) * rstd * gm.x + bt.x; v[s].y = (x.y - mean) * rstd * gm.y + bt.y;
        *(float2*)(p.out + O_SGUV + (size_t)(b * 8 + s) * 1024 + c0) = v[s];
    }
#pragma unroll
    for (int t = 0; t < 8; ++t) {
        float sx = p.b_s[g * 128 + t], sy = sx;
#pragma unroll
        for (int s = 0; s <= t; ++s) { const float w = p.w_s[(size_t)(g * 128 + t) * 128 + s]; sx += w * v[s].x; sy += w * v[s].y; }
        const size_t idx = (size_t)(row0 + t) * 1024 + c0;
        const unsigned uu = *(const unsigned*)(U + idx);
        *(unsigned*)(BOUT + idx) = cvt_pk_bf16(bflo(uu) * sx, bfhi(uu) * sy);
    }
}
__device__ void phase_mix(const P& p, unsigned char* smem) {
    const int bid = blockIdx.x, G = gridDim.x;
    const int NSC = 64;
    if (bid < NSC) {
        for (int s = bid; s < 64; s += NSC) { const int b = s >> 4, h = s & 15; scan_seq(p, smem, b * 2048, 2048, h, nullptr, p.out + O_WKVP + (size_t)s * 4096); }
        return;
    }
    const int j = bid - NSC, nb = G - NSC;
    {
#ifndef MIXSEL
#define MIXSEL 31
#endif
    if (MIXSEL & 1) for (int it = j; it < 512; it += nb) attn_item<true>(p, smem, it >> 2, it & 3, NP + (it >> 2) * 8);
    if (MIXSEL & 2) for (int it = j; it < 1024; it += nb) { const int b = it >> 8, h = (it >> 6) & 3, qt = it & 63; attn_item<false>(p, smem, b, h, b * 2048 + qt * 32); }
    if (MIXSEL & 4) for (int it = j; it < 512; it += nb) sgu_prompt_item(p, smem, it >> 7, (it >> 3) & 15, it & 7);
    if (MIXSEL & 8) for (int it = j; it < 128; it += nb) sgu_sample_item(p, it);
    if (MIXSEL & 16) for (int it = j; it < 2048; it += nb) { const int b = it >> 4, h = it & 15; scan_seq(p, smem, NP + b * 8, 8, h, p.st_wkv + (size_t)it * 4096, p.out + O_WKVS + (size_t)it * 4096); }
    }
    convert_tiles(p, smem, 7296, 18304, j, nb);
}

__device__ void phase_postmix(const P& p, unsigned char* smem) {
    int* tm = (int*)smem; build_tailmap(tm);
    const float* PART = (const float*)(p.ws + OFF_PART);
    const bf16_t* MIX = (const bf16_t*)(p.ws + OFF_MIX);
    float* H = (float*)(p.ws + OFF_H);
    bf16_t* HN = (bf16_t*)(p.ws + OFF_HN);
    const int lane = threadIdx.x & 63, wv = threadIdx.x >> 6;
    for (int r = blockIdx.x * 8 + wv; r < NTOK; r += gridDim.x * 8) {
        const float* x = r < NP ? p.x_p + (size_t)r * 2048 : p.x_s + (size_t)(r - NP) * 2048;
        const bf16_t* mr = MIX + (size_t)r * 2048;
        float4 v[8]; float ss = 0.f;
#pragma unroll
        for (int i = 0; i < 8; ++i) { const int tt = tm[(r >> 8) * 8 + i]; v[i] = tt < 0 ? ld4bf(mr + (i * 64 + lane) * 4) : sum_parts(PART, tt, r & 255, lane); ss += v[i].x * v[i].x + v[i].y * v[i].y + v[i].z * v[i].z + v[i].w * v[i].w; }
        const float r1 = rsqrtf(wsum(ss) * (1.f / 2048.f) + 1e-6f);
        float s2 = 0.f;
#pragma unroll
        for (int i = 0; i < 8; ++i) {
            const float4 xx = *(const float4*)(x + (i * 64 + lane) * 4), gg = *(const float4*)(p.g_post_mix + (i * 64 + lane) * 4);
            v[i].x = xx.x + v[i].x * r1 * gg.x; v[i].y = xx.y + v[i].y * r1 * gg.y; v[i].z = xx.z + v[i].z * r1 * gg.z; v[i].w = xx.w + v[i].w * r1 * gg.w;
            s2 += v[i].x * v[i].x + v[i].y * v[i].y + v[i].z * v[i].z + v[i].w * v[i].w;
            *(float4*)(H + (size_t)r * 2048 + (i * 64 + lane) * 4) = v[i];
        }
        const float r2 = rsqrtf(wsum(s2) * (1.f / 2048.f) + 1e-6f);
#pragma unroll
        for (int i = 0; i < 8; ++i) {
            const float4 gg = *(const float4*)(p.g_pre_ffn + (i * 64 + lane) * 4);
            uint2 pk; pk.x = cvt_pk_bf16(v[i].x * r2 * gg.x, v[i].y * r2 * gg.y); pk.y = cvt_pk_bf16(v[i].z * r2 * gg.z, v[i].w * r2 * gg.w);
            *(uint2*)(HN + (size_t)r * 2048 + (i * 64 + lane) * 4) = pk;
        }
    }
}
__device__ void phase_final(const P& p, unsigned char* smem) {
    int* tm = (int*)smem; build_tailmap(tm);
    const float* PART = (const float*)(p.ws + OFF_PART);
    const bf16_t* F = (const bf16_t*)(p.ws + OFF_F);
    const float* H = (const float*)(p.ws + OFF_H);
    const int lane = threadIdx.x & 63, wv = threadIdx.x >> 6;
    for (int r = blockIdx.x * 8 + wv; r < NTOK; r += gridDim.x * 8) {
        const bf16_t* fr = F + (size_t)r * 2048;
        float4 v[8]; float ss = 0.f;
#pragma unroll
        for (int i = 0; i < 8; ++i) { const int tt = tm[(r >> 8) * 8 + i]; v[i] = tt < 0 ? ld4bf(fr + (i * 64 + lane) * 4) : sum_parts(PART, tt, r & 255, lane); ss += v[i].x * v[i].x + v[i].y * v[i].y + v[i].z * v[i].z + v[i].w * v[i].w; }
        const float r1 = rsqrtf(wsum(ss) * (1.f / 2048.f) + 1e-6f);
#pragma unroll
        for (int i = 0; i < 8; ++i) {
            const float4 hh = *(const float4*)(H + (size_t)r * 2048 + (i * 64 + lane) * 4), gg = *(const float4*)(p.g_post_ffn + (i * 64 + lane) * 4);
            float4 o; o.x = hh.x + v[i].x * r1 * gg.x; o.y = hh.y + v[i].y * r1 * gg.y; o.z = hh.z + v[i].z * r1 * gg.z; o.w = hh.w + v[i].w * r1 * gg.w;
            *(float4*)(p.out + O_Y + (size_t)r * 2048 + (i * 64 + lane) * 4) = o;
        }
    }
}
__device__ __forceinline__ void ld8bf(const bf16_t* ptr, float (&o)[8]) {
    const uint4 u = *(const uint4*)ptr;
    o[0] = bflo(u.x); o[1] = bfhi(u.x); o[2] = bflo(u.y); o[3] = bfhi(u.y); o[4] = bflo(u.z); o[5] = bfhi(u.z); o[6] = bflo(u.w); o[7] = bfhi(u.w);
}
__device__ __forceinline__ void ld8f(const float* ptr, float (&o)[8]) {
    const float4 a = *(const float4*)ptr, b = *(const float4*)(ptr + 4);
    o[0] = a.x; o[1] = a.y; o[2] = a.z; o[3] = a.w; o[4] = b.x; o[5] = b.y; o[6] = b.z; o[7] = b.w;
}
__device__ void phase_conv(const P& p) {
    const bf16_t* UP = (const bf16_t*)(p.ws + OFF_UP);
    bf16_t* ACT = (bf16_t*)(p.ws + OFF_ACT);
    const int ntask = (NTOK / 8) * 704;
    for (int task = blockIdx.x * 512 + threadIdx.x; task < ntask; task += gridDim.x * 512) {
        const int rt = task / 704, cgp = task - rt * 704, row0 = rt * 8, cg0 = cgp * 8, cv0 = DFF + cgp * 8;
        float w0g[8], w1g[8], w2g[8], bg[8], w0v[8], w1v[8], w2v[8], bv[8];
        ld8f(p.conv_w + cg0, w0g); ld8f(p.conv_w + F2 + cg0, w1g); ld8f(p.conv_w + 2 * F2 + cg0, w2g); ld8f(p.conv_b + cg0, bg);
        ld8f(p.conv_w + cv0, w0v); ld8f(p.conv_w + F2 + cv0, w1v); ld8f(p.conv_w + 2 * F2 + cv0, w2v); ld8f(p.conv_b + cv0, bv);
        float e0g[8], e1g[8], e0v[8], e1v[8];
        if (row0 >= NP) {
            const float* st = p.st_conv + (size_t)(rt - NP / 8) * 2 * F2;
            ld8f(st + cg0, e0g); ld8f(st + F2 + cg0, e1g); ld8f(st + cv0, e0v); ld8f(st + F2 + cv0, e1v);
        } else if ((row0 & 2047) == 0) {
#pragma unroll
            for (int j = 0; j < 8; ++j) { e0g[j] = 0.f; e1g[j] = 0.f; e0v[j] = 0.f; e1v[j] = 0.f; }
        } else {
            ld8bf(UP + (size_t)(row0 - 2) * F2 + cg0, e0g); ld8bf(UP + (size_t)(row0 - 1) * F2 + cg0, e1g);
            ld8bf(UP + (size_t)(row0 - 2) * F2 + cv0, e0v); ld8bf(UP + (size_t)(row0 - 1) * F2 + cv0, e1v);
        }
        uint4 ugA[8], uvA[8];
#pragma unroll
        for (int t = 0; t < 8; ++t) { ugA[t] = *(const uint4*)(UP + (size_t)(row0 + t) * F2 + cg0); uvA[t] = *(const uint4*)(UP + (size_t)(row0 + t) * F2 + cv0); }
#pragma unroll
        for (int t = 0; t < 8; ++t) {
            float cgv[8], cvv[8];
            { const uint4 u = ugA[t]; cgv[0] = bflo(u.x); cgv[1] = bfhi(u.x); cgv[2] = bflo(u.y); cgv[3] = bfhi(u.y); cgv[4] = bflo(u.z); cgv[5] = bfhi(u.z); cgv[6] = bflo(u.w); cgv[7] = bfhi(u.w); }
            { const uint4 u = uvA[t]; cvv[0] = bflo(u.x); cvv[1] = bfhi(u.x); cvv[2] = bflo(u.y); cvv[3] = bfhi(u.y); cvv[4] = bflo(u.z); cvv[5] = bfhi(u.z); cvv[6] = bflo(u.w); cvv[7] = bfhi(u.w); }
            float o[8];
#pragma unroll
            for (int j = 0; j < 8; ++j) {
                const float gt = bg[j] + w0g[j] * e0g[j] + w1g[j] * e1g[j] + w2g[j] * cgv[j];
                const float vl = bv[j] + w0v[j] * e0v[j] + w1v[j] * e1v[j] + w2v[j] * cvv[j];
                o[j] = gelu_t(gt) * vl;
                e0g[j] = e1g[j]; e1g[j] = cgv[j]; e0v[j] = e1v[j]; e1v[j] = cvv[j];
            }
            uint4 pk; pk.x = cvt_pk_bf16(o[0], o[1]); pk.y = cvt_pk_bf16(o[2], o[3]); pk.z = cvt_pk_bf16(o[4], o[5]); pk.w = cvt_pk_bf16(o[6], o[7]);
            *(uint4*)(ACT + (size_t)(row0 + t) * DFF + cg0) = pk;
        }
    }
}

__device__ __forceinline__ unsigned xb_ld(unsigned* p) { return __hip_atomic_load(p, __ATOMIC_RELAXED, __HIP_MEMORY_SCOPE_AGENT); }
__device__ __forceinline__ unsigned xb_add(unsigned* p, unsigned v) { return __hip_atomic_fetch_add(p, v, __ATOMIC_RELAXED, __HIP_MEMORY_SCOPE_AGENT); }
__device__ __forceinline__ unsigned xb_xcc_id() { return (unsigned)__builtin_amdgcn_s_getreg((3 << 11) | 20) & 0xFu; }
#define XB_SPIN(cond) do { unsigned sp_ = 0; while (cond) { __builtin_amdgcn_s_sleep(1); if (++sp_ > (1u << 17)) break; } } while (0)
__device__ __forceinline__ void fast_grid_barrier(unsigned* bar, volatile unsigned* st) {
    asm volatile("s_waitcnt vmcnt(0)" ::: "memory");
    __syncthreads();
    if (threadIdx.x == 0) {
        const unsigned x = xb_xcc_id();
        const unsigned nloc = st[0], nx = st[1];
        const unsigned old = xb_add(&bar[64 * (16 + x)], 1u);
        const unsigned gen = old / nloc;
        if (old + 1u == (gen + 1u) * nloc) {
            __builtin_amdgcn_fence(__ATOMIC_RELEASE, "agent");
            asm volatile("s_waitcnt vmcnt(0)" ::: "memory");
            const unsigned og = xb_add(&bar[64 * 48], 1u);
            const unsigned tg = og / nx;
            if (og + 1u == (tg + 1u) * nx) (void)xb_add(&bar[64 * 49], 1u);
            else XB_SPIN(xb_ld(&bar[64 * 49]) == tg);
            __builtin_amdgcn_fence(__ATOMIC_ACQUIRE, "agent");
            (void)xb_add(&bar[64 * (32 + x)], 1u);
            asm volatile("s_waitcnt vmcnt(0)" ::: "memory");
        } else {
            XB_SPIN(xb_ld(&bar[64 * (32 + x)]) == gen);
            __builtin_amdgcn_fence(__ATOMIC_ACQUIRE, "agent");
            asm volatile("s_waitcnt vmcnt(0)" ::: "memory");
        }
    }
    __syncthreads();
}
__global__ void __launch_bounds__(512) fwd_kernel(P p) {
    extern __shared__ __attribute__((aligned(16))) unsigned char smem[];
    cg::grid_group grid = cg::this_grid();
    unsigned char* ws = p.ws;
    const int G = gridDim.x, c = blockIdx.x;
    const int lo = (int)p.ph_lo, hi = (int)p.ph_hi;
    unsigned* gbar = (unsigned*)(ws + OFF_BAR);
    __shared__ unsigned xb_state[2];
    if (threadIdx.x == 0) {
        const unsigned x = xb_xcc_id(); (void)xb_add(&gbar[64 * x], 1u);
        unsigned nloc = 1u, nx = 1u, sp = 0;
        for (;;) {
            unsigned sum = 0u, cnt = 0u, mine = 0u;
            for (unsigned j = 0; j < 16; ++j) { const unsigned cj = xb_ld(&gbar[64 * j]); sum += cj; cnt += (cj > 0u) ? 1u : 0u; mine = (j == x) ? cj : mine; }
            nloc = mine > 0u ? mine : 1u; nx = cnt > 0u ? cnt : 1u;
            if (sum == (unsigned)gridDim.x) break;
            __builtin_amdgcn_s_sleep(1); if (++sp > (1u << 17)) break;
        }
        xb_state[0] = nloc; xb_state[1] = nx;
    }
    __syncthreads();
    if (p.rep_mask == 0x7fffffffffffffffll) grid.sync();
#ifndef PH_MASK
#define PH_MASK 0x7ff
#endif
#define PHON(k) ((PH_MASK >> (k)) & 1)
#define PHRUN(k) (PHON(k) && lo <= (k) && (k) < hi)
#define PHSYNC(k) if (lo < (k) && (k) < hi) fast_grid_barrier(gbar, xb_state);
#ifdef TIMING_REPS
#define RUN_PHASE(k, ...) PHSYNC(k) if (PHRUN(k)) { const int nrep_ = 1 + (int)((p.rep_mask >> (k)) & 1); for (int rep_ = 0; rep_ < nrep_; ++rep_) { if (rep_) grid.sync(); __VA_ARGS__ } }
#else
#define RUN_PHASE(k, ...) PHSYNC(k) if (PHRUN(k)) { __VA_ARGS__ }
#endif
    RUN_PHASE(0, phase0(p, smem);)
    RUN_PHASE(1,
        pg8::Gemm g{(const bf16_t*)(ws + OFF_XN), (const bf16_t*)(ws + OFF_WIN), NTOK, 12544, 2048};
        pg8::StaticOrder S; S.init(NTOK, 12544, 2048, G, c);
        EpiProj E{(float*)(ws + OFF_RW), (bf16_t*)(ws + OFF_U), (float*)(ws + OFF_GV), (bf16_t*)(ws + OFF_Q), (bf16_t*)(ws + OFF_GT), p.out};
        pg8::gemm_phase((LAS unsigned char*)smem, g, S, E);
        )
    RUN_PHASE(2, phase_prep(p, smem);
        pg8::Gemm g2{(const bf16_t*)(ws + OFF_MN), (const bf16_t*)(ws + OFF_WMEM), 1024, 2048, 2048};
        pg8::StaticOrder S2; S2.init(1024, 2048, 2048, G, G - 1 - c);
        EpiMem E2{p.out, (bf16_t*)(ws + OFF_MKB), (bf16_t*)(ws + OFF_MVT)};
        pg8::gemm_phase((LAS unsigned char*)smem, g2, S2, E2);)
    RUN_PHASE(3, phase_mix(p, smem);)
    RUN_PHASE(4,
        pg8::Gemm g{(const bf16_t*)(ws + OFF_BR), (const bf16_t*)(ws + OFF_WBR), NTOK, 2048, 1024};
        pg8::BranchOrder S{G, c};
        EpiBranch E{(const bf16_t*)(ws + OFF_GT), (bf16_t*)(ws + OFF_MIXSUM), (float*)(ws + OFF_PART)};
        pg8::gemm_phase((LAS unsigned char*)smem, g, S, E);)
    if (lo <= 4 && 5 < hi) { fast_grid_barrier(gbar, xb_state); reduce_branch_tail((const float*)(ws + OFF_PART), (bf16_t*)(ws + OFF_MIXSUM)); }
    RUN_PHASE(5,
        pg8::Gemm g{(const bf16_t*)(ws + OFF_MIXSUM), (const bf16_t*)(ws + OFF_WOUT), NTOK, 2048, 2048};
        pg8::TailSplitOrder S{c, 32};
        EpiF32 E{(bf16_t*)(ws + OFF_MIX), 2048, (float*)(ws + OFF_PART)};
        pg8::gemm_phase((LAS unsigned char*)smem, g, S, E);)
    RUN_PHASE(6, phase_postmix(p, smem);)
    RUN_PHASE(7,
        pg8::Gemm g{(const bf16_t*)(ws + OFF_HN), (const bf16_t*)(ws + OFF_WUP), NTOK, F2, 2048};
        pg8::StaticOrder S; S.init(NTOK, F2, 2048, G, c);
        EpiUp E{(bf16_t*)(ws + OFF_UP), p.out};
        pg8::gemm_phase((LAS unsigned char*)smem, g, S, E);)
    RUN_PHASE(8, phase_conv(p);)
    RUN_PHASE(9,
        pg8::Gemm g{(const bf16_t*)(ws + OFF_ACT), (const bf16_t*)(ws + OFF_WDOWN), NTOK, 2048, DFF};
        pg8::TailSplitOrder S{c, 88};
        EpiF32 E{(bf16_t*)(ws + OFF_F), 2048, (float*)(ws + OFF_PART)};
        pg8::gemm_phase((LAS unsigned char*)smem, g, S, E);)
    RUN_PHASE(10, phase_final(p, smem);)
}

#ifndef MK_MULTI
#define MK_MULTI 0
#endif
extern "C" void kernel_launch(void* const* d_in, const int* in_sizes, int n_in, void* d_out, int out_size, void* d_ws, size_t ws_size, hipStream_t stream) {
    static int grid = 0;
    if (grid == 0) {
        if (n_in != 37 || ws_size < WS_END) { fprintf(stderr, "kernel_launch: bad n_in %d or ws_size %zu < %zu\n", n_in, ws_size, (size_t)WS_END); grid = -1; return; }
        int dev = 0, cus = 0, per_cu = 0;
        hipGetDevice(&dev);
        hipDeviceGetAttribute(&cus, hipDeviceAttributeMultiprocessorCount, dev);
        if (hipFuncSetAttribute((const void*)fwd_kernel, hipFuncAttributeMaxDynamicSharedMemorySize, LDS_BYTES) != hipSuccess) { fprintf(stderr, "hipFuncSetAttribute failed\n"); grid = -1; return; }
        if (hipOccupancyMaxActiveBlocksPerMultiprocessor(&per_cu, (const void*)fwd_kernel, 512, LDS_BYTES) != hipSuccess || per_cu < 1) { fprintf(stderr, "occupancy query failed (%d)\n", per_cu); grid = -1; return; }
        grid = cus * per_cu;
        if (grid > 256) grid = 256;
    }
    if (grid != 256) return;
    P p{};
    const float** pp = (const float**)&p;
    for (int i = 0; i < 37; ++i) pp[i] = (const float*)d_in[i];
    p.out = (float*)d_out; p.ws = (unsigned char*)d_ws;
#if MK_MULTI
    for (int ph = 0; ph < NPHASE; ++ph) {
        p.ph_lo = ph; p.ph_hi = ph + 1;
        hipLaunchKernelGGL(fwd_kernel, dim3(grid), dim3(512), LDS_BYTES, stream, p);
    }
#else
    p.ph_lo = 0; p.ph_hi = NPHASE;
    if (hipMemsetAsync((unsigned char*)d_ws + OFF_BAR, 0, 50 * 256, stream) != hipSuccess) { fprintf(stderr, "memset of barrier words failed\n"); return; }
#ifdef TIMING_REPS
    p.rep_mask = TIMING_REPS;
#endif
    void* args[] = {&p};
    hipError_t e = hipLaunchCooperativeKernel((const void*)fwd_kernel, dim3(grid), dim3(512), args, LDS_BYTES, stream);
    if (e != hipSuccess) fprintf(stderr, "cooperative launch failed: %s (grid %d)\n", hipGetErrorString(e), grid);
#endif
}
```
